# Optimizing an MI355X kernel written in HIP

```python
import math
import jax, jax.numpy as jnp
from jax import lax
import numpy as np

D_MODEL = 1024
BATCH = 16
SEQ = 2048
DEPTH = 2

N_META = 16
BLOCK = 128
WINDOW = 128
A_HEADS = 8
A_KV_HEADS = 2
A_HEAD_DIM = 64
A_WIDTH = A_HEADS * A_HEAD_DIM
B_HEADS = 8
B_NOPE_DIM = 64
B_ROPE_DIM = 32
B_V_DIM = 64
B_WIDTH = B_HEADS * B_V_DIM
Q_LORA_RANK = 256
KV_LORA_RANK = 128
MIX_WIDTH = A_WIDTH + B_WIDTH
IN_SIZES = (A_WIDTH, A_KV_HEADS * A_HEAD_DIM, A_KV_HEADS * A_HEAD_DIM, A_WIDTH,
            Q_LORA_RANK, KV_LORA_RANK, B_ROPE_DIM, B_WIDTH)
IN_WIDTH = 2 * A_WIDTH + 2 * A_KV_HEADS * A_HEAD_DIM + Q_LORA_RANK + KV_LORA_RANK + B_ROPE_DIM + B_WIDTH
N_BUCKETS = 32
MAX_DISTANCE = 128
ROPE_THETA = 10000.0
EPS = 1e-6

kernel_name = "hymba_swa_mla_hybrid_encoder"


def rms_norm(x, g):
    xf = x.astype(jnp.float32)
    y = xf * lax.rsqrt(jnp.mean(xf * xf, axis=-1, keepdims=True) + EPS)
    return (y * g.astype(jnp.float32)).astype(x.dtype)


def t5_bucket(rel):
    nb = N_BUCKETS // 2
    max_exact = nb // 2
    ret = jnp.where(rel > 0, nb, 0)
    n = jnp.abs(rel)
    nf = jnp.maximum(n, 1).astype(jnp.float32)
    large = max_exact + (jnp.log(nf / max_exact) / math.log(MAX_DISTANCE / max_exact)
                         * (nb - max_exact)).astype(jnp.int32)
    large = jnp.minimum(large, nb - 1)
    return ret + jnp.where(n < max_exact, n, large)


def rel_bias(table, q_pos, k_pos):
    b = t5_bucket(k_pos[..., None, :] - q_pos[..., :, None])
    return jnp.moveaxis(table.astype(jnp.float32)[b], -1, -3)


def softmax_with_sink(logits, sink, mask):
    logits = jnp.where(mask, logits, -jnp.inf)
    s = sink.astype(jnp.float32)[:, None, None]
    m = jnp.maximum(jnp.max(logits, axis=-1, keepdims=True), s)
    e = jnp.exp(logits - m)
    return e / (jnp.sum(e, axis=-1, keepdims=True) + jnp.exp(s - m))


def apply_rope(x, cos, sin):
    x1, x2 = jnp.split(x.astype(jnp.float32), 2, axis=-1)
    return jnp.concatenate([x1 * cos - x2 * sin, x2 * cos + x1 * sin], axis=-1).astype(x.dtype)


def window_attention(q, k, v, sink, table):
    B, L = q.shape[0], q.shape[1]
    S = L - N_META
    nb = S // BLOCK
    g = A_HEADS // A_KV_HEADS
    dh = A_HEAD_DIM
    scale = dh ** -0.5
    q = q.reshape(B, L, A_KV_HEADS, g, dh)
    qm, qr = q[:, :N_META], q[:, N_META:]
    km, kr = k[:, :N_META], k[:, N_META:]
    vm, vr = v[:, :N_META], v[:, N_META:]

    qb = qr.reshape(B, nb, BLOCK, A_KV_HEADS, g, dh)
    pad = ((0, 0), (BLOCK, BLOCK), (0, 0), (0, 0))

    def band(t, tm):
        tp = jnp.pad(t, pad).reshape(B, nb + 2, BLOCK, A_KV_HEADS, dh)
        tb = jnp.concatenate([tp[:, :-2], tp[:, 1:-1], tp[:, 2:]], axis=2)
        tmb = jnp.broadcast_to(tm[:, None], (B, nb, N_META, A_KV_HEADS, dh))
        return jnp.concatenate([tmb, tb], axis=2)

    kb, vb = band(kr, km), band(vr, vm)
    blk = jnp.arange(nb)[:, None]
    q_idx = blk * BLOCK + jnp.arange(BLOCK)[None, :]
    k_idx = (blk - 1) * BLOCK + jnp.arange(3 * BLOCK)[None, :]
    valid = ((k_idx[:, None, :] >= 0) & (k_idx[:, None, :] < S)
             & (jnp.abs(q_idx[:, :, None] - k_idx[:, None, :]) <= WINDOW))
    mask = jnp.concatenate([jnp.ones((nb, BLOCK, N_META), bool), valid], axis=-1)
    q_pos = N_META + q_idx
    k_pos = jnp.concatenate([jnp.broadcast_to(jnp.arange(N_META)[None], (nb, N_META)), N_META + k_idx], axis=-1)
    bias = rel_bias(table, q_pos, k_pos)
    logits = jnp.einsum('bnqhgd,bnkhd->bnhgqk', qb, kb).astype(jnp.float32) * scale
    logits = logits.reshape(B, nb, A_HEADS, BLOCK, N_META + 3 * BLOCK) + bias[None]
    p = softmax_with_sink(logits, sink, mask[None, :, None]).astype(v.dtype)
    p = p.reshape(B, nb, A_KV_HEADS, g, BLOCK, N_META + 3 * BLOCK)
    out_r = jnp.einsum('bnhgqk,bnkhd->bnqhgd', p, vb).reshape(B, S, A_WIDTH)

    km2 = jnp.concatenate([km, kr[:, :BLOCK]], axis=1)
    vm2 = jnp.concatenate([vm, vr[:, :BLOCK]], axis=1)
    qp = jnp.arange(N_META)
    kp = jnp.arange(N_META + BLOCK)
    mmask = jnp.abs(kp[None, :] - qp[:, None]) <= WINDOW
    mbias = rel_bias(table, qp, kp)
    ml = jnp.einsum('bqhgd,bkhd->bhgqk', qm, km2).astype(jnp.float32) * scale
    ml = ml.reshape(B, A_HEADS, N_META, N_META + BLOCK) + mbias[None]
    mp = softmax_with_sink(ml, sink, mmask).astype(v.dtype).reshape(B, A_KV_HEADS, g, N_META, N_META + BLOCK)
    out_m = jnp.einsum('bhgqk,bkhd->bqhgd', mp, vm2).reshape(B, N_META, A_WIDTH)
    return jnp.concatenate([out_m, out_r], axis=1)


def mla_attention(q_nope, q_rope, k_nope, k_rope, v):
    B, L = q_nope.shape[0], q_nope.shape[1]
    S = L - N_META
    nb = S // BLOCK
    scale = (B_NOPE_DIM + B_ROPE_DIM) ** -0.5

    def attend(qn, qr):
        logits = (jnp.einsum('bqhd,bkhd->bhqk', qn, k_nope)
                  + jnp.einsum('bqhd,bkd->bhqk', qr, k_rope)).astype(jnp.float32) * scale
        p = jax.nn.softmax(logits, axis=-1).astype(v.dtype)
        return jnp.einsum('bhqk,bkhd->bqhd', p, v)

    out_m = attend(q_nope[:, :N_META], q_rope[:, :N_META]).reshape(B, N_META, B_WIDTH)
    qn_b = jnp.moveaxis(q_nope[:, N_META:].reshape(B, nb, BLOCK, B_HEADS, B_NOPE_DIM), 1, 0)
    qr_b = jnp.moveaxis(q_rope[:, N_META:].reshape(B, nb, BLOCK, B_HEADS, B_ROPE_DIM), 1, 0)
    out_r = lax.map(lambda a: attend(a[0], a[1]), (qn_b, qr_b))
    out_r = jnp.moveaxis(out_r, 0, 1).reshape(B, S, B_WIDTH)
    return jnp.concatenate([out_m, out_r], axis=1)


def hybrid_layer(h, norm_in, w_in, sink_a, norm_q_lat, w_uq, norm_kv_lat, w_ukv,
                 norm_out_a, norm_out_b, w_out, rel_table, cos, sin):
    B, L = h.shape[0], h.shape[1]
    u = rms_norm(h, norm_in)
    proj = jnp.einsum('bld,de->ble', u, w_in)
    offsets = np.cumsum(IN_SIZES)[:-1].tolist()
    qa, ka, va, ga, cq, ckv, kr, gb = jnp.split(proj, offsets, axis=-1)

    ya = window_attention(qa.reshape(B, L, A_HEADS, A_HEAD_DIM),
                          ka.reshape(B, L, A_KV_HEADS, A_HEAD_DIM),
                          va.reshape(B, L, A_KV_HEADS, A_HEAD_DIM), sink_a, rel_table)

    q = jnp.einsum('blr,re->ble', rms_norm(cq, norm_q_lat), w_uq).reshape(B, L, B_HEADS, B_NOPE_DIM + B_ROPE_DIM)
    q_nope, q_rope = q[..., :B_NOPE_DIM], q[..., B_NOPE_DIM:]
    q_rope = apply_rope(q_rope, cos[:, None], sin[:, None])
    kv = jnp.einsum('blr,re->ble', rms_norm(ckv, norm_kv_lat), w_ukv).reshape(B, L, B_HEADS, B_NOPE_DIM + B_V_DIM)
    k_nope, vb = kv[..., :B_NOPE_DIM], kv[..., B_NOPE_DIM:]
    k_rope = apply_rope(kr, cos, sin)
    yb = mla_attention(q_nope, q_rope, k_nope, k_rope, vb)

    y = jnp.concatenate([rms_norm(ya, norm_out_a) * jax.nn.silu(ga),
                         rms_norm(yb, norm_out_b) * jax.nn.silu(gb)], axis=-1)
    return h + jnp.einsum('ble,ed->bld', y, w_out)


def setup_inputs(seed: int = 0) -> dict:
    key = jax.random.key(seed)
    ks = jax.random.split(key, 16)
    f32 = jnp.float32
    nrm = lambda k, s, sc: jax.random.normal(k, s, f32) * sc
    gain = lambda k, s: 1.0 + 0.1 * jax.random.normal(k, s, f32)
    return {
        "x": nrm(ks[0], (BATCH, SEQ, D_MODEL), 1.0),
        "meta_tokens": nrm(ks[1], (N_META, D_MODEL), 1.0),
        "rel_bias_table": nrm(ks[2], (N_BUCKETS, A_HEADS), 0.5),
        "norm_in": gain(ks[3], (DEPTH, D_MODEL)),
        "w_in": nrm(ks[4], (DEPTH, D_MODEL, IN_WIDTH), D_MODEL ** -0.5),
        "sink_a": nrm(ks[5], (DEPTH, A_HEADS), 0.5),
        "norm_q_lat": gain(ks[6], (DEPTH, Q_LORA_RANK)),
        "w_uq": nrm(ks[7], (DEPTH, Q_LORA_RANK, B_HEADS * (B_NOPE_DIM + B_ROPE_DIM)), Q_LORA_RANK ** -0.5),
        "norm_kv_lat": gain(ks[8], (DEPTH, KV_LORA_RANK)),
        "w_ukv": nrm(ks[9], (DEPTH, KV_LORA_RANK, B_HEADS * (B_NOPE_DIM + B_V_DIM)), KV_LORA_RANK ** -0.5),
        "norm_out_a": gain(ks[10], (DEPTH, A_WIDTH)),
        "norm_out_b": gain(ks[11], (DEPTH, B_WIDTH)),
        "w_out": nrm(ks[12], (DEPTH, MIX_WIDTH, D_MODEL), MIX_WIDTH ** -0.5),
        "norm_final": gain(ks[13], (D_MODEL,)),
    }


def reference(x, meta_tokens, rel_bias_table, norm_in, w_in, sink_a, norm_q_lat, w_uq,
              norm_kv_lat, w_ukv, norm_out_a, norm_out_b, w_out, norm_final):
    B = x.shape[0]
    meta = jnp.broadcast_to(meta_tokens.astype(x.dtype)[None], (B, N_META, D_MODEL))
    h = jnp.concatenate([meta, x], axis=1)
    L = h.shape[1]
    half = B_ROPE_DIM // 2
    freqs = ROPE_THETA ** (-jnp.arange(half, dtype=jnp.float32) / half)
    ang = jnp.arange(L, dtype=jnp.float32)[:, None] * freqs[None, :]
    cos, sin = jnp.cos(ang), jnp.sin(ang)
    for i in range(DEPTH):
        h = hybrid_layer(h, norm_in[i], w_in[i], sink_a[i], norm_q_lat[i], w_uq[i], norm_kv_lat[i],
                         w_ukv[i], norm_out_a[i], norm_out_b[i], w_out[i], rel_bias_table, cos, sin)
    return rms_norm(h[:, N_META:], norm_final)
```

```cpp
#include <hip/hip_runtime.h>
#include <hip/hip_cooperative_groups.h>
#include <cstdio>
#include <cstdint>
namespace cg = cooperative_groups;

#ifndef PROBE_REP
#define PROBE_REP 0
#endif
#ifndef PROBE_ABL
#define PROBE_ABL 0
#endif
#ifndef USE_CG_SYNC
#define USE_CG_SYNC 0
#endif
constexpr int DM = 1024, NBATCH = 16, SEQ = 2048, NMETA = 16, LTOK = SEQ + NMETA, MROWS = NBATCH * LTOK;
constexpr int MPAD = MROWS + 256;
constexpr int INW = 2208, N1 = 2304;
constexpr int NTHREADS = 512;
constexpr float EPS = 1e-6f;
constexpr float LOG2E = 1.4426950408889634f;
constexpr float QA_SCALE = 0.125f * LOG2E;
constexpr float QB_SCALE = 0.10206207261596577f * LOG2E;
constexpr int BIASW = 4128;

typedef unsigned short bf16_t;
typedef float nt_f4 __attribute__((ext_vector_type(4)));
typedef unsigned int u32;

__device__ __forceinline__ float bf2f(bf16_t v) { return __uint_as_float(((u32)v) << 16); }
__device__ __forceinline__ bf16_t f2bf(float f) { u32 u = __float_as_uint(f); u = (u + 0x7fffu + ((u >> 16) & 1u)) >> 16; return (bf16_t)u; }

constexpr size_t al256(size_t x) { return (x + 255) & ~(size_t)255; }
constexpr size_t OFF_CTL = 0;
constexpr size_t CTL_BYTES = 32768;
constexpr size_t OFF_COS = CTL_BYTES;
constexpr size_t OFF_SIN = OFF_COS + al256((size_t)LTOK * 16 * 4);
constexpr size_t OFF_BIAS = OFF_SIN + al256((size_t)LTOK * 16 * 4);
constexpr size_t OFF_A2T = OFF_BIAS + al256((size_t)8 * BIASW * 4);
constexpr size_t OFF_SSQH = OFF_A2T + al256((size_t)2 * 2560 * 4);
constexpr size_t OFF_SSQY = OFF_SSQH + al256((size_t)16 * MROWS * 4);
constexpr size_t OFF_SSQC = OFF_SSQY + al256((size_t)32 * MROWS * 4);
constexpr size_t OFF_W1T = OFF_SSQC + al256((size_t)8 * MROWS * 4);
constexpr size_t OFF_W2QT = OFF_W1T + al256((size_t)2 * N1 * 1024 * 2);
constexpr size_t OFF_W3T = OFF_W2QT + al256((size_t)2 * 1792 * 256 * 2);
constexpr size_t OFF_H = OFF_W3T + al256((size_t)2 * 1024 * 1024 * 2);
constexpr size_t OFF_QA = OFF_H + al256((size_t)MPAD * 1024 * 2);
constexpr size_t OFF_KA = OFF_QA + al256((size_t)MPAD * 512 * 2);
constexpr size_t OFF_VA = OFF_KA + al256((size_t)MPAD * 128 * 2);
constexpr size_t OFF_GAS = OFF_VA + al256((size_t)MPAD * 128 * 2);
constexpr size_t OFF_GBS = OFF_GAS + al256((size_t)MPAD * 512 * 2);
constexpr size_t OFF_CQ = OFF_GBS + al256((size_t)MPAD * 512 * 2);
constexpr size_t OFF_QBN = OFF_CQ + al256((size_t)MPAD * 512 * 2);
constexpr size_t OFF_QBR = OFF_QBN + al256((size_t)MPAD * 512 * 2);
constexpr size_t OFF_KNB = OFF_QBR + al256((size_t)MPAD * 256 * 2);
constexpr size_t OFF_VB = OFF_KNB + al256((size_t)MPAD * 512 * 2);
constexpr size_t OFF_Y = OFF_VB + al256((size_t)MPAD * 512 * 2);
constexpr size_t WS_END = OFF_Y + al256((size_t)MPAD * 1024 * 2);

struct Params {
    const float* x; const float* meta; const float* relb; const float* norm_in; const float* w_in; const float* sink; const float* norm_q; const float* w_uq;
    const float* norm_kv; const float* w_ukv; const float* norm_oa; const float* norm_ob; const float* w_out; const float* norm_f;
    float* out; unsigned char* ws;
};

struct Bufs {
    unsigned char* ws;
#define BUF_F(name, off) __device__ __forceinline__ float* name() const { return (float*)(ws + (off)); }
#define BUF_H(name, off) __device__ __forceinline__ bf16_t* name() const { return (bf16_t*)(ws + (off)); }
    BUF_F(cosT, OFF_COS) BUF_F(sinT, OFF_SIN) BUF_F(bias, OFF_BIAS) BUF_F(ssqh, OFF_SSQH) BUF_F(ssqy, OFF_SSQY) BUF_F(ssqc, OFF_SSQC)
    BUF_H(w1t, OFF_W1T) BUF_H(w2, OFF_W2QT) BUF_H(w3t, OFF_W3T) BUF_H(H, OFF_H) BUF_H(QA, OFF_QA) BUF_H(KA, OFF_KA) BUF_H(VA, OFF_VA)
    BUF_H(GAS, OFF_GAS) BUF_H(GBS, OFF_GBS) BUF_H(CQX, OFF_CQ) BUF_H(QBN, OFF_QBN) BUF_H(QBR, OFF_QBR) BUF_H(KNB, OFF_KNB) BUF_H(VB, OFF_VB) BUF_H(Y, OFF_Y)
#undef BUF_F
#undef BUF_H
};
__device__ __forceinline__ Bufs make_bufs(unsigned char* ws) { Bufs b; b.ws = ws; return b; }

__device__ __forceinline__ float wave_sum(float v) {
#pragma unroll
    for (int o = 1; o < 64; o <<= 1) v += __shfl_xor(v, o);
    return v;
}
__device__ __forceinline__ int t5_bucket(int rel) {
    const int ret = rel > 0 ? 16 : 0; const int n = rel < 0 ? -rel : rel;
    int b;
    if (n < 8) b = n;
    else b = n >= 91 ? 15 : n >= 64 ? 14 : n >= 46 ? 13 : n >= 32 ? 12 : n >= 23 ? 11 : n >= 16 ? 10 : n >= 12 ? 9 : 8;
    return ret + b;
}

__device__ __forceinline__ void transpose_item(const float* W, int ldw, const float* gain, int k0, int kvalid, int srcbase, bool perm, bool zero, bf16_t* WT, int Kd, int n0, float* scr, int lane) {
#pragma unroll 4
    for (int i = 0; i < 32; ++i) {
        const int kk = 2 * i + (lane >> 5), c = lane & 31, k = k0 + kk;
        float v = 0.f;
        if (!zero && k < kvalid) { const int sc = srcbase + (perm ? ((c >> 1) + 16 * (c & 1)) : c); v = W[(size_t)k * ldw + sc]; if (gain) v *= gain[k]; }
        scr[kk * 33 + c] = v;
    }
    __builtin_amdgcn_s_waitcnt(0xc07f); asm volatile("" ::: "memory");
    const int c8 = lane & 7;
#pragma unroll
    for (int j = 0; j < 4; ++j) {
        const int n = (lane >> 3) + 8 * j; const float* s = scr + (8 * c8) * 33 + n;
        uint4 o;
        o.x = (u32)f2bf(s[0 * 33]) | ((u32)f2bf(s[1 * 33]) << 16); o.y = (u32)f2bf(s[2 * 33]) | ((u32)f2bf(s[3 * 33]) << 16);
        o.z = (u32)f2bf(s[4 * 33]) | ((u32)f2bf(s[5 * 33]) << 16); o.w = (u32)f2bf(s[6 * 33]) | ((u32)f2bf(s[7 * 33]) << 16);
        *(uint4*)(WT + (size_t)(n0 + n) * Kd + k0 + 8 * c8) = o;
    }
    __builtin_amdgcn_s_waitcnt(0xc07f); asm volatile("" ::: "memory");
}

__device__ __forceinline__ void phase_prologue(const Params& p, const Bufs& B, float* lds) {
    const int tid = threadIdx.x, lane = tid & 63, wave = tid >> 6;
    const int gw = blockIdx.x * 8 + wave, NGW = gridDim.x * 8;
    float* scr = lds + wave * (64 * 33);
    constexpr int I1 = 16 * 72;
    constexpr int I2 = 4 * 24;
    constexpr int I3 = 4 * 32;
    constexpr int I4 = 16 * 32;
    constexpr int IL = I1 + I2 + I3 + I4;
    for (int it = gw; it < 2 * IL; it += NGW) {
        const int l = it / IL; int r = it % IL;
        if (r < I1) {
            const int kb = r / 72, nb = r % 72, n0 = nb * 32;
            int srcbase = 0; bool perm = false, zero = false;
            if (n0 < 1280) srcbase = n0;
            else if (n0 < 1792) srcbase = 1696 + (n0 - 1280);
            else if (n0 < 2048) srcbase = 1280 + (n0 - 1792);
            else { const int j = n0 - 2048; if (j < 128) srcbase = 1536 + j; else if (j < 160) { srcbase = 1664; perm = true; } else zero = true; }
            transpose_item(p.w_in + (size_t)l * 1024 * INW, INW, p.norm_in + l * 1024, kb * 64, 1024, srcbase, perm, zero, B.w1t() + (size_t)l * N1 * 1024, 1024, n0, scr, lane);
            continue;
        }
        r -= I1;
        if (r < I2) {
            const int kb = r / 24, nb = r % 24, n0 = nb * 32;
            int srcbase; bool perm = false;
            if (n0 < 512) { const int h = n0 / 64, d0 = n0 % 64; srcbase = 96 * h + d0; }
            else { const int h = (n0 - 512) / 32; srcbase = 96 * h + 64; perm = true; }
            transpose_item(p.w_uq + (size_t)l * 256 * 768, 768, p.norm_q + l * 256, kb * 64, 256, srcbase, perm, false, B.w2() + (size_t)l * 1792 * 256, 256, n0, scr, lane);
            continue;
        }
        r -= I2;
        if (r < I3) {
            const int kb = r / 32, nb = r % 32, n0 = nb * 32;
            int srcbase;
            if (n0 < 512) { const int h = n0 / 64, d0 = n0 % 64; srcbase = 128 * h + d0; }
            else { const int j = n0 - 512, h = j / 64, d0 = j % 64; srcbase = 128 * h + 64 + d0; }
            transpose_item(p.w_ukv + (size_t)l * 128 * 1024, 1024, p.norm_kv + l * 128, kb * 64, 128, srcbase, false, false, B.w2() + (size_t)l * 1792 * 256 + (size_t)768 * 256, 256, n0, scr, lane);
            continue;
        }
        r -= I3;
        {
            const int kb = r / 32, nb = r % 32, n0 = nb * 32;
            transpose_item(p.w_out + (size_t)l * 1024 * 1024, 1024, nullptr, kb * 64, 1024, n0, false, false, B.w3t() + (size_t)l * 1024 * 1024, 1024, n0, scr, lane);
        }
    }
    for (int r0 = gw * 4; r0 < MROWS; r0 += NGW * 4) {
        float4 v[4][4];
#pragma unroll
        for (int q = 0; q < 4; ++q) {
            const int r = r0 + q, b = r / LTOK, pp = r % LTOK;
            const float* src = pp < NMETA ? p.meta + (size_t)pp * DM : p.x + ((size_t)b * SEQ + (pp - NMETA)) * DM;
#pragma unroll
            for (int j = 0; j < 4; ++j) { const nt_f4 t_ = __builtin_nontemporal_load((const nt_f4*)(src + j * 256 + lane * 4)); v[q][j] = make_float4(t_.x, t_.y, t_.z, t_.w); }
        }
#pragma unroll
        for (int q = 0; q < 4; ++q) {
            const int r = r0 + q; float s = 0.f;
#pragma unroll
            for (int j = 0; j < 4; ++j) {
                const float4 w = v[q][j];
                s += w.x * w.x + w.y * w.y + w.z * w.z + w.w * w.w;
                uint2 o; o.x = (u32)f2bf(w.x) | ((u32)f2bf(w.y) << 16); o.y = (u32)f2bf(w.z) | ((u32)f2bf(w.w) << 16);
                *(uint2*)(B.H() + (size_t)r * DM + j * 256 + lane * 4) = o;
            }
            s = wave_sum(s);
            if (lane < 16) B.ssqh()[(size_t)lane * MROWS + r] = lane == 0 ? s : 0.f;
        }
    }
    const int gt = blockIdx.x * NTHREADS + tid, NGT = gridDim.x * NTHREADS;
    if (gt < 1024) ((unsigned*)(p.ws + OFF_CTL))[gt] = 0u;
    for (int i = gt; i < 64 * 512 / 8; i += NGT) ((uint4*)(B.VB() + (size_t)MROWS * 512))[i] = make_uint4(0u, 0u, 0u, 0u);
    for (int i = gt; i < LTOK * 16; i += NGT) {
        const int pos = i >> 4, j = i & 15;
        const float freq = exp2f(-(float)j * (13.287712379549449f / 16.0f));
        const float ang = (float)pos * freq;
        B.cosT()[i] = cosf(ang); B.sinT()[i] = sinf(ang);
    }
    for (int i = gt; i < 8 * BIASW; i += NGT) {
        const int h = i / BIASW, rel = (i % BIASW) - LTOK;
        B.bias()[i] = p.relb[t5_bucket(rel) * 8 + h] * LOG2E;
    }
    for (int i = gt; i < 2 * 2560; i += NGT) {
        const int g = i / 2560, t = (i % 2560) / 1280, j = i % 1280, hq = j / 320, rel = (j % 320) - 160;
        const float bv = p.relb[t5_bucket(rel) * 8 + 4 * g + hq] * LOG2E;
        ((float*)(B.ws + OFF_A2T))[i] = (t == 0 && (rel < -128 || rel > 128)) ? -INFINITY : bv;
    }
}

__device__ __forceinline__ float row_rs16(const float* part, int r, float inv_n) {
    float s = 0.f;
#pragma unroll
    for (int i = 0; i < 16; ++i) s += part[(size_t)i * MROWS + r];
    return rsqrtf(s * inv_n + EPS);
}


namespace pg8 {
#define PG8_LAS __attribute__((address_space(3)))
typedef short bf16x8 __attribute__((ext_vector_type(8)));
typedef float f32x4 __attribute__((ext_vector_type(4)));
typedef unsigned u32x4 __attribute__((ext_vector_type(4)));
constexpr int BM = 256, BK = 64, HALF = 128, HTB = HALF * BK * 2, STAGE_BYTES = 8 * HTB, NXCD = 8, WGM = 8;
constexpr int XTRA_OFF = STAGE_BYTES;
constexpr int MAXU = 6;

__device__ __forceinline__ int lds_byte(int r, int c) { const int st = (r >> 4) * 2 + (c >> 5), rr = r & 15, cc = c & 31, ob = rr * 64 + cc * 2; return st * 1024 + (ob ^ (((ob >> 9) & 1) << 5)); }
__device__ __forceinline__ void stage_rc(int b, int& R, int& C) { const int st = b / 1024, sb = b % 1024, swz = sb ^ (((sb >> 9) & 1) << 5); R = (st >> 1) * 16 + swz / 64; C = (st & 1) * 32 + (swz % 64) / 2; }
__device__ __forceinline__ int perm32(int rho) { const int n = rho >> 4, i = rho & 15; return 8 * (i >> 2) + 4 * n + (i & 3); }

struct Unit { int pm, pn; };
struct Gemm { const bf16_t* A; const bf16_t* Bt; int M, N, K; int lda = 0  ; int asplit = 1 << 30, aoffc = 0  , k2 = 0  ; };
struct StaticOrder {
    int nM, nN, nwg, G, c;
    __device__ void init(int M, int N, int G_, int c_) { nM = M / BM; nN = N / BM; nwg = nM * nN; G = G_; c = c_; }
    __device__ bool next(int i, Unit& u) const {
        const long L = (long)i * G + c; if (L >= nwg) return false;
        int wgid = (int)L; { const int q = nwg / NXCD, r = nwg % NXCD, xcd = wgid % NXCD, off = wgid / NXCD; wgid = (xcd < r ? xcd * (q + 1) : r * (q + 1) + (xcd - r) * q) + off; }
        const int nig = WGM * nN, gid = wgid / nig, fm = gid * WGM, gsz = (nM - fm) < WGM ? (nM - fm) : WGM;
        u.pm = fm + ((wgid % nig) % gsz); u.pn = (wgid % nig) / gsz; return true;
    }
};
__device__ __forceinline__ unsigned cvt_pk_bf16(float lo, float hi) { unsigned r; asm volatile("v_cvt_pk_bf16_f32 %0, %1, %2" : "=v"(r) : "v"(lo), "v"(hi)); return r; }

template <class Epi>
__device__ __forceinline__ void gemm_phase(PG8_LAS unsigned char* lds, const Gemm g, const StaticOrder& S, const Epi& E) {
    int tid_ = threadIdx.x; asm volatile("" : "+v"(tid_));
    const int tid = tid_, wid = __builtin_amdgcn_readfirstlane(tid >> 6), lane = tid & 63, wr = wid >> 2, wc = wid & 3, fr = lane & 15, fq = lane >> 4;
    const int K = g.K, nt = K / BK, lda = g.lda ? g.lda : g.K;
    unsigned voffA[2], voffB[2];
#pragma unroll
    for (int i = 0; i < 2; ++i) { int R, C; stage_rc(tid * 16 + i * 8192, R, C); const int Rb = Epi::PERM ? ((R & ~31) + perm32(R & 31)) : R;
        voffA[i] = (unsigned)(R * lda + C) * 2u; voffB[i] = (unsigned)(Rb * K + C) * 2u; }
    const size_t kstep = (size_t)(BK * 2);
    const size_t hstep = (size_t)HALF * K * 2, hstepA = (size_t)HALF * lda * 2;
    const size_t tstep = 2 * hstep, tstepA = 2 * hstepA;
#define PG8_ABASE(u) ((const char*)g.A + (size_t)(u).pm * tstepA + ((u).pn >= g.asplit ? (size_t)g.aoffc * 2 : (size_t)0))
    const unsigned ldsw = (unsigned)wid * 1024u;
    const int aoff = lds_byte(wr * 64 + fr, fq * 8), boff = lds_byte(wc * 32 + fr, fq * 8);
#define PG8_SA(b, h) (((b) * 2 + (h)) * HTB)
#define PG8_SB(b, h) ((4 + (b) * 2 + (h)) * HTB)
#define PG8_STAGE(bufoff, gbase, voff) do { _Pragma("unroll") for (int _i = 0; _i < 2; ++_i) \
        __builtin_amdgcn_global_load_lds((const unsigned*)((const char*)(gbase) + (voff)[_i]), (PG8_LAS unsigned*)(lds + (bufoff) + ldsw + _i * 8192), 16, 0, 0); } while (0)
#define PG8_LDA(dst, b, h) do { _Pragma("unroll") for (int m = 0; m < 4; ++m) _Pragma("unroll") for (int k = 0; k < 2; ++k) dst[m][k] = *(const PG8_LAS bf16x8*)(lds + PG8_SA(b, h) + aoff + m * 2048 + k * 1024); } while (0)
#define PG8_LDB(dst, b, h) do { _Pragma("unroll") for (int n = 0; n < 2; ++n) _Pragma("unroll") for (int k = 0; k < 2; ++k) dst[n][k] = *(const PG8_LAS bf16x8*)(lds + PG8_SB(b, h) + boff + n * 2048 + k * 1024); } while (0)
#define PG8_MMA(ai, bj, At, Bt) do { __builtin_amdgcn_s_setprio(1); _Pragma("unroll") for (int m = 0; m < 4; ++m) _Pragma("unroll") for (int n = 0; n < 2; ++n) _Pragma("unroll") for (int k = 0; k < 2; ++k) \
        acc[ai][bj][m][n] = __builtin_amdgcn_mfma_f32_16x16x32_bf16(Bt[n][k], At[m][k], acc[ai][bj][m][n], 0, 0, 0); __builtin_amdgcn_s_setprio(0); } while (0)
#define PG8_WAIT_V(n) asm volatile("s_waitcnt vmcnt(" #n ")" ::: "memory")
#define PG8_WAIT_L(n) asm volatile("s_waitcnt lgkmcnt(" #n ")" ::: "memory")
#define PG8_BAR __builtin_amdgcn_s_barrier()
#define PG8_SCHED __builtin_amdgcn_sched_barrier(0)
    Unit cur, nxt; int ui = 0;
    if (!S.next(0, cur)) return;
    f32x4 acc[2][2][4][2];
#pragma unroll
    for (int a = 0; a < 2; ++a)
#pragma unroll
        for (int b = 0; b < 2; ++b)
#pragma unroll
            for (int m = 0; m < 4; ++m)
#pragma unroll
                for (int n = 0; n < 2; ++n) acc[a][b][m][n] = (f32x4){0.f, 0.f, 0.f, 0.f};
    bf16x8 At[4][2], B0[2][2], B1[2][2];
    const char* cA = PG8_ABASE(cur); const char* cB = (const char*)g.Bt + (size_t)cur.pn * tstep;
    PG8_STAGE(PG8_SB(0, 0), cB, voffB); PG8_STAGE(PG8_SB(0, 1), cB + hstep, voffB); PG8_STAGE(PG8_SA(0, 0), cA, voffA); PG8_STAGE(PG8_SA(0, 1), cA + hstepA, voffA);
    if (wr == 1) PG8_BAR;
    PG8_WAIT_V(2); PG8_BAR;
    PG8_STAGE(PG8_SB(1, 0), cB + kstep, voffB); PG8_STAGE(PG8_SA(1, 0), cA + kstep, voffA); PG8_STAGE(PG8_SB(1, 1), cB + hstep + kstep, voffB);
    PG8_WAIT_V(6); PG8_BAR;
    for (;;) {
        const bool has_next = S.next(ui + 1, nxt);
        const char* nA = has_next ? PG8_ABASE(nxt) : cA; const char* nB = has_next ? (const char*)g.Bt + (size_t)nxt.pn * tstep : cB;
        PG8_LAS const float* xs = (PG8_LAS const float*)(lds + XTRA_OFF) + ui * 512;
        const int ntu = (g.k2 && cur.pn >= g.asplit) ? g.k2 / BK : nt;
#pragma unroll 1
        for (int t = 0; t < ntu; t += 2) {
            const bool last = (t == ntu - 2);
            const char* a1 = cA + (size_t)(t + 1) * kstep;
            const char* a2 = last ? nA : cA + (size_t)(t + 2) * kstep; const char* b2 = last ? nB : cB + (size_t)(t + 2) * kstep;
            const char* a3 = a2 + kstep; const char* b3 = b2 + kstep;
            if constexpr (Epi::HAS_MID) { if (t == (ntu >> 1)) E.mid(acc, wr, fr, xs); }
            PG8_LDB(B0, 0, 0); PG8_LDB(B1, 0, 1); PG8_SCHED; PG8_LDA(At, 0, 0); PG8_STAGE(PG8_SA(1, 1), a1 + hstepA, voffA);
            PG8_WAIT_V(8); PG8_WAIT_L(0); PG8_BAR; PG8_MMA(0, 0, At, B0); PG8_MMA(0, 1, At, B1); PG8_BAR; PG8_SCHED;
            PG8_LDA(At, 0, 1); PG8_STAGE(PG8_SB(0, 0), b2, voffB); PG8_STAGE(PG8_SB(0, 1), b2 + hstep, voffB); PG8_STAGE(PG8_SA(0, 0), a2, voffA);
            PG8_WAIT_V(8); PG8_WAIT_L(0); PG8_BAR; PG8_MMA(1, 0, At, B0); PG8_MMA(1, 1, At, B1); PG8_BAR; PG8_SCHED;
            PG8_LDB(B0, 1, 0); PG8_LDB(B1, 1, 1); PG8_SCHED; PG8_LDA(At, 1, 0); PG8_STAGE(PG8_SA(0, 1), a2 + hstepA, voffA);
            PG8_WAIT_V(8); PG8_WAIT_L(0); PG8_BAR; PG8_MMA(0, 0, At, B0); PG8_MMA(0, 1, At, B1); PG8_BAR; PG8_SCHED;
            PG8_LDA(At, 1, 1); PG8_STAGE(PG8_SB(1, 0), b3, voffB); PG8_STAGE(PG8_SB(1, 1), b3 + hstep, voffB); PG8_STAGE(PG8_SA(1, 0), a3, voffA);
            PG8_WAIT_V(8); PG8_WAIT_L(0); PG8_BAR; PG8_MMA(1, 0, At, B0); PG8_MMA(1, 1, At, B1); PG8_BAR; PG8_SCHED;
        }
        if (wr == 0) PG8_BAR;
        E(acc, cur, wr, wc, fr, fq, xs);
        if (!has_next) break;
#pragma unroll
        for (int a = 0; a < 2; ++a)
#pragma unroll
            for (int b = 0; b < 2; ++b)
#pragma unroll
                for (int m = 0; m < 4; ++m)
#pragma unroll
                    for (int n = 0; n < 2; ++n) acc[a][b][m][n] = (f32x4){0.f, 0.f, 0.f, 0.f};
        cur = nxt; cA = nA; cB = nB; ++ui;
        if (wr == 1) PG8_BAR;
    }
    PG8_WAIT_V(0);
    PG8_BAR;
#undef PG8_ABASE
#undef PG8_SA
#undef PG8_SB
#undef PG8_STAGE
#undef PG8_LDA
#undef PG8_LDB
#undef PG8_MMA
#undef PG8_WAIT_V
#undef PG8_WAIT_L
#undef PG8_BAR
#undef PG8_SCHED
}

template <class F>
__device__ __forceinline__ void fill_row_scalars(PG8_LAS unsigned char* lds, const StaticOrder& S, const F& f) {
    PG8_LAS float* xs = (PG8_LAS float*)(lds + XTRA_OFF);
    Unit u; const int row = threadIdx.x & 255, j = threadIdx.x >> 8;
    for (int i = 0; i < MAXU && S.next(i, u); ++i) xs[i * 512 + j * 256 + row] = f(j, u.pm * BM + row);
    __syncthreads();
}
}

__device__ __forceinline__ float fast_silu(float v) { return v * __builtin_amdgcn_rcpf(1.0f + __builtin_amdgcn_exp2f(-v * LOG2E)); }

__device__ __forceinline__ size_t qfrag_idx(size_t r, int h, int d, int nks, int sh = 0) {
    const int b = (int)(r / LTOK), P = (int)(r - (size_t)b * LTOK) + sh;
    return (((((size_t)(b * 65 + (P >> 5)) * 8 + h) * nks + (d >> 4)) * 2 + ((d >> 3) & 1)) * 32 + (P & 31)) * 8;
}
constexpr int QB_SHIFT = 16;
__device__ __forceinline__ size_t qfrag_blk(int b, int blk, int h, int ks, int hi, int nks) { return ((((size_t)(b * 65 + blk) * 8 + h) * nks + ks) * 2 + hi) * 256; }

struct EpiInProj {
    static constexpr bool PERM = true, HAS_MID = false;
    Bufs B; const float* goa; const float* gob;
    template <int KIND>
    __device__ __forceinline__ void tile(const pg8::f32x4 (&acc)[2][2][4][2], const pg8::Unit& u, int wr, int wc, int fr, int fq, PG8_LAS const float* xs) const {
        using pg8::f32x4; using pg8::u32x4; using pg8::cvt_pk_bf16;
        const int pn = u.pn, cl = wc * 32 + 8 * fq;
        const int rl0 = wr * 64 + fr; const size_t r0 = (size_t)u.pm * 256 + rl0;
        bf16_t* d0; bf16_t* d1; int ld;
        const float* gg = nullptr;
        if (KIND == 0) { ld = 512; d0 = B.QA() + r0 * 512 + pn * 256 + cl; d1 = d0 + 128; }
        else if (KIND == 1) { ld = 128; d0 = B.KA() + r0 * 128 + cl; d1 = B.VA() + r0 * 128 + cl; }
        else if (KIND == 2) { ld = 512; const int c = ((pn - 3) & 1) * 256 + cl; gg = (pn < 5 ? goa : gob) + c; d0 = (pn < 5 ? B.GAS() : B.GBS()) + r0 * 512 + c; d1 = d0 + 128; }
        else if (KIND == 3) { ld = 512; d0 = B.CQX() + r0 * 512 + cl; d1 = d0 + 128; }
        else { ld = 512; d0 = B.CQX() + r0 * 512 + 256 + cl; d1 = d0 + 128; }
        f32x4 g[2][2];
        if (KIND == 2) { g[0][0] = *(const f32x4*)gg; g[0][1] = *(const f32x4*)(gg + 4); g[1][0] = *(const f32x4*)(gg + 128); g[1][1] = *(const f32x4*)(gg + 132); }
#pragma unroll
        for (int ai = 0; ai < 2; ++ai)
#pragma unroll
            for (int m = 0; m < 4; ++m) {
                const int ro = ai * 128 + m * 16; const float rs = xs[rl0 + ro];
                float ssq = 0.f;
#pragma unroll
                for (int bj = 0; bj < 2; ++bj) {
                    f32x4 v0 = acc[ai][bj][m][0] * rs, v1 = acc[ai][bj][m][1] * rs;
                    if (KIND == 0) { v0 = v0 * QA_SCALE; v1 = v1 * QA_SCALE; }
                    if (KIND == 2) {
                        const float rsn = rs * -LOG2E;
                        const f32x4 t0 = acc[ai][bj][m][0] * rsn, t1 = acc[ai][bj][m][1] * rsn;
                        f32x4 e0, e1;
#pragma unroll
                        for (int j = 0; j < 4; ++j) { e0[j] = __builtin_amdgcn_exp2f(t0[j]); e1[j] = __builtin_amdgcn_exp2f(t1[j]); }
                        e0 = e0 + 1.0f; e1 = e1 + 1.0f;
                        f32x4 s0, s1;
#pragma unroll
                        for (int j = 0; j < 4; ++j) { s0[j] = __builtin_amdgcn_rcpf(e0[j]); s1[j] = __builtin_amdgcn_rcpf(e1[j]); }
                        v0 = (v0 * g[bj][0]) * s0; v1 = (v1 * g[bj][1]) * s1;
                    }
                    if (KIND == 3 || (KIND == 4 && bj == 0))
                        ssq += (v0[0] * v0[0] + v0[1] * v0[1]) + (v0[2] * v0[2] + v0[3] * v0[3]) + (v1[0] * v1[0] + v1[1] * v1[1]) + (v1[2] * v1[2] + v1[3] * v1[3]);
                    if (KIND == 4 && bj == 1) {
                        if (wc == 0) {
                            const int pos = (int)((r0 + ro) % LTOK);
                            const f32x4 cs = *(const f32x4*)(B.cosT() + pos * 16 + 4 * fq), sn = *(const f32x4*)(B.sinT() + pos * 16 + 4 * fq);
                            const f32x4 a0 = v0, a1 = v1;
                            v0[0] = a0[0] * cs[0] - a0[1] * sn[0]; v0[1] = a0[1] * cs[0] + a0[0] * sn[0]; v0[2] = a0[2] * cs[1] - a0[3] * sn[1]; v0[3] = a0[3] * cs[1] + a0[2] * sn[1];
                            v1[0] = a1[0] * cs[2] - a1[1] * sn[2]; v1[1] = a1[1] * cs[2] + a1[0] * sn[2]; v1[2] = a1[2] * cs[3] - a1[3] * sn[3]; v1[3] = a1[3] * cs[3] + a1[2] * sn[3];
                        }
                    }
                    u32x4 w; w.x = cvt_pk_bf16(v0[0], v0[1]); w.y = cvt_pk_bf16(v0[2], v0[3]); w.z = cvt_pk_bf16(v1[0], v1[1]); w.w = cvt_pk_bf16(v1[2], v1[3]);
                    if (KIND == 0) { const int c = pn * 256 + bj * 128 + cl; *(u32x4*)(B.QA() + qfrag_idx(r0 + ro, c >> 6, c & 63, 4)) = w; }
                    else *(u32x4*)((bj == 0 ? d0 : d1) + (size_t)ro * ld) = w;
                }
                if (KIND >= 3) {
                    ssq += __shfl_xor(ssq, 16); ssq += __shfl_xor(ssq, 32);
                    if (fq == 0) B.ssqc()[(size_t)((KIND - 3) * 4 + wc) * MROWS + r0 + ro] = ssq;
                }
                asm volatile("" ::: "memory");
            }
    }
    __device__ __forceinline__ void operator()(const pg8::f32x4 (&acc)[2][2][4][2], const pg8::Unit& u, int wr, int wc, int fr, int fq, PG8_LAS const float* xs) const {
        const int pn = u.pn;
        if (pn < 2) tile<0>(acc, u, wr, wc, fr, fq, xs);
        else if (pn == 2) tile<1>(acc, u, wr, wc, fr, fq, xs);
        else if (pn < 7) tile<2>(acc, u, wr, wc, fr, fq, xs);
        else if (pn == 7) tile<3>(acc, u, wr, wc, fr, fq, xs);
        else tile<4>(acc, u, wr, wc, fr, fq, xs);
    }
};
struct RowScalarH { const float* ssqh; __device__ __forceinline__ float operator()(int j, int r) const { return j == 0 ? row_rs16(ssqh, r, 1.0f / 1024.0f) : 0.f; } };

__device__ __forceinline__ void phase_inproj(PG8_LAS unsigned char* lds, const Params& p, const Bufs& B, int l) {
    pg8::Gemm g{B.H(), B.w1t() + (size_t)l * N1 * 1024, MROWS, N1, 1024}; pg8::StaticOrder S; S.init(MROWS, N1, gridDim.x, blockIdx.x);
    pg8::fill_row_scalars(lds, S, RowScalarH{B.ssqh()});
    EpiInProj E{B, p.norm_oa + l * 512, p.norm_ob + l * 512};
    pg8::gemm_phase(lds, g, S, E);
}

__device__ __forceinline__ float rs_c(const float* ssqc, int base, int r, float inv_n) {
    const float s = ssqc[(size_t)(base + 0) * MROWS + r] + ssqc[(size_t)(base + 1) * MROWS + r] + ssqc[(size_t)(base + 2) * MROWS + r] + ssqc[(size_t)(base + 3) * MROWS + r];
    return rsqrtf(s * inv_n + EPS);
}

struct EpiUp {
    static constexpr bool PERM = true, HAS_MID = false;
    Bufs B;
    template <int WHICH>
    __device__ __forceinline__ void tile(const pg8::f32x4 (&acc)[2][2][4][2], const pg8::Unit& u, int pn, int wr, int wc, int fr, int fq, PG8_LAS const float* xs) const {
        using pg8::f32x4; using pg8::u32x4; using pg8::cvt_pk_bf16;
        const int cl = wc * 32 + 8 * fq;
        const int rl0 = wr * 64 + fr; const size_t r0 = (size_t)u.pm * 256 + rl0;
        const bool rope = (WHICH == 0 && pn == 2);
        bf16_t* d0; int ld;
        if (WHICH == 0) { if (pn < 2) { ld = 512; d0 = B.QBN() + r0 * 512 + pn * 256 + cl; } else { ld = 256; d0 = B.QBR() + r0 * 256 + cl; } }
        else { ld = 512; d0 = (pn < 2 ? B.KNB() : B.VB()) + r0 * 512 + (pn & 1) * 256 + cl; }
        const float sc = (WHICH == 0) ? QB_SCALE : 1.0f;
#pragma unroll
        for (int ai = 0; ai < 2; ++ai)
#pragma unroll
            for (int m = 0; m < 4; ++m) {
                const int ro = ai * 128 + m * 16; const float rs = xs[WHICH * 256 + rl0 + ro] * sc;
                f32x4 cs, sn;
                if (rope) { const int pos = (int)((r0 + ro) % LTOK); cs = *(const f32x4*)(B.cosT() + pos * 16 + 4 * fq); sn = *(const f32x4*)(B.sinT() + pos * 16 + 4 * fq); }
#pragma unroll
                for (int bj = 0; bj < 2; ++bj) {
                    f32x4 v0 = acc[ai][bj][m][0] * rs, v1 = acc[ai][bj][m][1] * rs;
                    if (rope) {
                        const f32x4 a0 = v0, a1 = v1;
                        v0[0] = a0[0] * cs[0] - a0[1] * sn[0]; v0[1] = a0[1] * cs[0] + a0[0] * sn[0]; v0[2] = a0[2] * cs[1] - a0[3] * sn[1]; v0[3] = a0[3] * cs[1] + a0[2] * sn[1];
                        v1[0] = a1[0] * cs[2] - a1[1] * sn[2]; v1[1] = a1[1] * cs[2] + a1[0] * sn[2]; v1[2] = a1[2] * cs[3] - a1[3] * sn[3]; v1[3] = a1[3] * cs[3] + a1[2] * sn[3];
                    }
                    u32x4 w; w.x = cvt_pk_bf16(v0[0], v0[1]); w.y = cvt_pk_bf16(v0[2], v0[3]); w.z = cvt_pk_bf16(v1[0], v1[1]); w.w = cvt_pk_bf16(v1[2], v1[3]);
                    if (WHICH == 0) { const int c = (pn < 2 ? pn * 256 : 0) + bj * 128 + cl;
                        if (pn < 2) *(u32x4*)(B.QBN() + qfrag_idx(r0 + ro, c >> 6, c & 63, 4, QB_SHIFT)) = w; else *(u32x4*)(B.QBR() + qfrag_idx(r0 + ro, c >> 5, c & 31, 2, QB_SHIFT)) = w; }
                    else *(u32x4*)(d0 + bj * 128 + (size_t)ro * ld) = w;
                }
                asm volatile("" ::: "memory");
            }
    }
    __device__ __forceinline__ void operator()(const pg8::f32x4 (&acc)[2][2][4][2], const pg8::Unit& u, int wr, int wc, int fr, int fq, PG8_LAS const float* xs) const {
        if (u.pn < 3) tile<0>(acc, u, u.pn, wr, wc, fr, fq, xs); else tile<1>(acc, u, u.pn - 3, wr, wc, fr, fq, xs);
    }
};
struct RowScalarC { const float* ssqc; __device__ __forceinline__ float operator()(int j, int r) const { return j == 0 ? rs_c(ssqc, 0, r, 1.0f / 256.0f) : rs_c(ssqc, 4, r, 1.0f / 128.0f); } };
__device__ __forceinline__ void phase_upproj(PG8_LAS unsigned char* lds, const Bufs& B, int l) {
    pg8::Gemm g{B.CQX(), B.w2() + (size_t)l * 1792 * 256, MROWS, 1792, 256, 512, 3, 256, 128}; pg8::StaticOrder S; S.init(MROWS, 1792, gridDim.x, blockIdx.x);
    pg8::fill_row_scalars(lds, S, RowScalarC{B.ssqc()});
    EpiUp E{B}; pg8::gemm_phase(lds, g, S, E);
}

struct EpiOut {
    static constexpr bool PERM = true, HAS_MID = true;
    bf16_t* H; float* ssqh;
    __device__ __forceinline__ void mid(pg8::f32x4 (&acc)[2][2][4][2], int wr, int fr, PG8_LAS const float* xs) const {
#pragma unroll
        for (int ai = 0; ai < 2; ++ai)
#pragma unroll
            for (int m = 0; m < 4; ++m) { const float f = xs[ai * 128 + wr * 64 + m * 16 + fr];
#pragma unroll
                for (int bj = 0; bj < 2; ++bj)
#pragma unroll
                    for (int n = 0; n < 2; ++n) acc[ai][bj][m][n] = acc[ai][bj][m][n] * f; }
    }
    __device__ __forceinline__ void operator()(const pg8::f32x4 (&acc)[2][2][4][2], const pg8::Unit& u, int wr, int wc, int fr, int fq, PG8_LAS const float* xs) const {
        using pg8::f32x4; using pg8::u32x4; using pg8::cvt_pk_bf16;
        const int pn = u.pn, cl = wc * 32 + 8 * fq;
        const int rl0 = wr * 64 + fr; const size_t r0 = (size_t)u.pm * 256 + rl0;
        bf16_t* d0 = H + r0 * DM + pn * 256 + cl;
#pragma unroll
        for (int ai = 0; ai < 2; ++ai) {
            u32x4 hv[4][2];
#pragma unroll
            for (int m = 0; m < 4; ++m)
#pragma unroll
                for (int bj = 0; bj < 2; ++bj) hv[m][bj] = *(const u32x4*)(d0 + bj * 128 + (size_t)(ai * 128 + m * 16) * DM);
#pragma unroll
            for (int m = 0; m < 4; ++m) {
                const int ro = ai * 128 + m * 16; const float rb = xs[256 + rl0 + ro];
                float ssq = 0.f;
#pragma unroll
                for (int bj = 0; bj < 2; ++bj) {
                    bf16_t* dp = d0 + bj * 128 + (size_t)ro * DM;
                    const u32x4 h4 = hv[m][bj];
                    f32x4 v0 = acc[ai][bj][m][0] * rb, v1 = acc[ai][bj][m][1] * rb;
                    v0[0] += __uint_as_float(h4.x << 16); v0[1] += __uint_as_float(h4.x & 0xffff0000u); v0[2] += __uint_as_float(h4.y << 16); v0[3] += __uint_as_float(h4.y & 0xffff0000u);
                    v1[0] += __uint_as_float(h4.z << 16); v1[1] += __uint_as_float(h4.z & 0xffff0000u); v1[2] += __uint_as_float(h4.w << 16); v1[3] += __uint_as_float(h4.w & 0xffff0000u);
                    ssq += (v0[0] * v0[0] + v0[1] * v0[1]) + (v0[2] * v0[2] + v0[3] * v0[3]) + (v1[0] * v1[0] + v1[1] * v1[1]) + (v1[2] * v1[2] + v1[3] * v1[3]);
                    u32x4 w; w.x = cvt_pk_bf16(v0[0], v0[1]); w.y = cvt_pk_bf16(v0[2], v0[3]); w.z = cvt_pk_bf16(v1[0], v1[1]); w.w = cvt_pk_bf16(v1[2], v1[3]);
                    *(u32x4*)dp = w;
                }
                ssq += __shfl_xor(ssq, 16); ssq += __shfl_xor(ssq, 32);
                if (fq == 0) ssqh[(size_t)(pn * 4 + wc) * MROWS + r0 + ro] = ssq;
            }
            asm volatile("" ::: "memory");
        }
    }
};
struct RowScalarY {
    const float* ssqy;
    __device__ __forceinline__ float operator()(int j, int r) const {
        float sa = 0.f, sb = 0.f;
#pragma unroll
        for (int i = 0; i < 16; ++i) { sa += ssqy[(size_t)i * MROWS + r]; sb += ssqy[(size_t)(16 + i) * MROWS + r]; }
        const float ra = rsqrtf(sa * (1.0f / 512.0f) + EPS), rb = rsqrtf(sb * (1.0f / 512.0f) + EPS);
        return j == 0 ? ra / rb : rb;
    }
};
__device__ __forceinline__ void outproj_tail(PG8_LAS unsigned char* lds, const Bufs& B, int l) {
    typedef short bf16x8 __attribute__((ext_vector_type(8))); typedef float f32x4 __attribute__((ext_vector_type(4)));
    for (int c = blockIdx.x; c < 256; c += gridDim.x) {
        int tid_ = threadIdx.x; asm volatile("" : "+v"(tid_));
        const int tid = tid_, lane = tid & 63, wid = __builtin_amdgcn_readfirstlane(tid >> 6);
        const int rg = c >> 4, cg = c & 15, r0 = (MROWS - 256) + 16 * rg, n0 = 64 * cg;
        PG8_LAS float* part = (PG8_LAS float*)lds;
        PG8_LAS float* rsc = part + 8 * 1024;
        if (tid < 32) {
            const int row = tid & 15, j = tid >> 4; float sa = 0.f;
#pragma unroll
            for (int i = 0; i < 16; ++i) sa += B.ssqy()[(size_t)(16 * j + i) * MROWS + r0 + row];
            rsc[j * 16 + row] = rsqrtf(sa * (1.0f / 512.0f) + EPS);
        }
        const int fr = lane & 15, kq = lane >> 4;
        f32x4 acc[4];
#pragma unroll
        for (int cb = 0; cb < 4; ++cb) acc[cb] = (f32x4){0.f, 0.f, 0.f, 0.f};
        const bf16_t* Ap = B.Y() + (size_t)(r0 + fr) * 1024 + wid * 128 + kq * 8;
        const bf16_t* Bp = B.w3t() + (size_t)l * 1024 * 1024 + (size_t)(n0 + fr) * 1024 + wid * 128 + kq * 8;
#pragma unroll
        for (int ks = 0; ks < 4; ++ks) {
            const bf16x8 a = *(const bf16x8*)(Ap + ks * 32);
#pragma unroll
            for (int cb = 0; cb < 4; ++cb) { const bf16x8 bb = *(const bf16x8*)(Bp + (size_t)cb * 16 * 1024 + ks * 32); acc[cb] = __builtin_amdgcn_mfma_f32_16x16x32_bf16(a, bb, acc[cb], 0, 0, 0); }
        }
        __syncthreads();
#pragma unroll
        for (int i = 0; i < 4; ++i) { const int row = 4 * kq + i; const float sc = rsc[(wid >> 2) * 16 + row];
#pragma unroll
            for (int cb = 0; cb < 4; ++cb) part[wid * 1024 + row * 64 + cb * 16 + fr] = acc[cb][i] * sc; }
        __syncthreads();
        const int row = tid >> 5, cp = tid & 31;
        float s0 = 0.f, s1 = 0.f;
#pragma unroll
        for (int w = 0; w < 8; ++w) { s0 += part[w * 1024 + row * 64 + 2 * cp]; s1 += part[w * 1024 + row * 64 + 2 * cp + 1]; }
        unsigned* hp = (unsigned*)(B.H() + (size_t)(r0 + row) * DM + n0 + 2 * cp);
        const unsigned hv = *hp;
        const float v0 = __uint_as_float(hv << 16) + s0, v1 = __uint_as_float(hv & 0xffff0000u) + s1;
        *hp = pg8::cvt_pk_bf16(v0, v1);
        float ss = v0 * v0 + v1 * v1;
#pragma unroll
        for (int o = 1; o < 32; o <<= 1) ss += __shfl_xor(ss, o);
        if (cp == 0) B.ssqh()[(size_t)cg * MROWS + r0 + row] = ss;
        __syncthreads();
    }
}
__device__ __forceinline__ void phase_outproj(PG8_LAS unsigned char* lds, const Bufs& B, int l) {
    outproj_tail(lds, B, l);
    pg8::Gemm g{B.Y(), B.w3t() + (size_t)l * 1024 * 1024, MROWS - 256, 1024, 1024}; pg8::StaticOrder S; S.init(MROWS - 256, 1024, gridDim.x, blockIdx.x);
    pg8::fill_row_scalars(lds, S, RowScalarY{B.ssqy()});
    EpiOut E{B.H(), B.ssqh()}; pg8::gemm_phase(lds, g, S, E);
}

namespace att {
#define ATT_LAS __attribute__((address_space(3)))
typedef short bf16x8 __attribute__((ext_vector_type(8)));
typedef float f32x16 __attribute__((ext_vector_type(16)));
typedef short s16x4 __attribute__((ext_vector_type(4)));
typedef short v4i16_t __attribute__((ext_vector_type(4)));
typedef unsigned u32x4 __attribute__((ext_vector_type(4)));
constexpr int KBUF = 0, KTILE_MAX = 64 * 208, VBUF = 2 * KTILE_MAX, WSF = VBUF + 2 * 8192, OST = WSF + 2048, BIASL = OST + 8 * 4096, LDS_END = BIASL + BIASW * 4, UWORD = 147456 - 128;
constexpr float THR = 8.0f;
constexpr int NUNITS = 1024 + 544 + 128;
__device__ __forceinline__ int crow(int r, int hi) { return (r & 3) + 8 * (r >> 2) + 4 * hi; }
typedef float f32x2_t __attribute__((ext_vector_type(2))); typedef __bf16 bf16x2_t __attribute__((ext_vector_type(2)));
__device__ __forceinline__ unsigned cvtpk(float lo, float hi) { f32x2_t v = {lo, hi}; bf16x2_t b = __builtin_convertvector(v, bf16x2_t); return __builtin_bit_cast(unsigned, b); }
__device__ __forceinline__ s16x4 vtr(ATT_LAS const unsigned char* p) { return __builtin_bit_cast(s16x4, __builtin_amdgcn_ds_read_tr16_b64_v4i16((ATT_LAS v4i16_t*)p)); }

template <int TYPE, bool NORMALIZED = false>
__device__ __forceinline__ void attn_store(const Bufs& B, const f32x16& o0, const f32x16& o1, float lsum, int b, int h, int Pw, ATT_LAS unsigned char* lds, int wid, int lane, int wsf_off = WSF, int ost_off = OST, bool dummy = false) {
    const int r32 = lane & 31, hi = lane >> 5; const size_t rb = (size_t)b * LTOK;
    ATT_LAS float* wsf = (ATT_LAS float*)(lds + wsf_off) + wid * 64;
    if (!NORMALIZED) { lsum += __shfl_xor(lsum, 32); if (hi == 0) wsf[32 + r32] = lsum; }
    ATT_LAS bf16_t* stg = (ATT_LAS bf16_t*)(lds + ost_off + wid * 4096);
#pragma unroll
    for (int r = 0; r < 16; ++r) {
        const int qr = crow(r, hi); const float rinv = NORMALIZED ? 1.0f : __builtin_amdgcn_rcpf(wsf[32 + qr]);
        stg[qr * 64 + r32] = f2bf(o0[r] * rinv); stg[qr * 64 + 32 + r32] = f2bf(o1[r] * rinv);
    }
    const bf16_t* G = (TYPE == 0 ? B.GAS() : B.GBS());
    const int ch = lane & 7;
#pragma unroll
    for (int i = 0; i < 4; ++i) {
        const int row = i * 8 + (lane >> 3), Pr = Pw + row;
        const u32x4 ov = *(ATT_LAS const u32x4*)(stg + row * 64 + ch * 8);
        const bool ok = Pr < LTOK; const size_t grow = rb + (ok ? Pr : LTOK - 1);
        const u32x4 gv = *(const u32x4*)(G + grow * 512 + h * 64 + ch * 8);
        const unsigned ou[4] = {ov.x, ov.y, ov.z, ov.w}, gu[4] = {gv.x, gv.y, gv.z, gv.w}; unsigned yw[4]; float ss = 0.f;
#pragma unroll
        for (int j = 0; j < 4; ++j) {
            const float a0 = __uint_as_float(ou[j] << 16), a1 = __uint_as_float(ou[j] & 0xffff0000u);
            ss += a0 * a0 + a1 * a1;
            yw[j] = cvtpk(a0 * __uint_as_float(gu[j] << 16), a1 * __uint_as_float(gu[j] & 0xffff0000u));
        }
        ss += __shfl_xor(ss, 1); ss += __shfl_xor(ss, 2); ss += __shfl_xor(ss, 4);
        if (ok) {
            bf16_t* Yb = dummy ? (bf16_t*)(B.ws + WS_END) : B.Y(); float* sq = dummy ? (float*)(B.ws + WS_END + (size_t)MPAD * 2048) : B.ssqy();
            *(u32x4*)(Yb + grow * 1024 + TYPE * 512 + h * 64 + ch * 8) = (u32x4){yw[0], yw[1], yw[2], yw[3]};
            if (ch == 0) { sq[(size_t)((TYPE * 8 + h) * 2) * MROWS + grow] = ss; sq[(size_t)((TYPE * 8 + h) * 2 + 1) * MROWS + grow] = 0.f; }
        }
    }
}

constexpr int B_KSLOT = 64 * 208, B_NSK = 4, B_NSV = 4, B_KRING = 0, B_VRING = B_NSK * B_KSLOT, B_DUMP = B_VRING + B_NSV * 8192, B_WSF = B_DUMP + 8192, B_OST = B_WSF + 2048, B_END = B_OST + 8 * 4096;
static_assert(B_END <= 143360, "B unit LDS map");
__device__ __forceinline__ int imin(int a, int b) { return a < b ? a : b; }
__device__ __forceinline__ void glds16(const void* gsrc, unsigned lds_dst) { unsigned keep;
    asm volatile("s_mov_b32 %0, m0\n\ts_mov_b32 m0, %2\n\ts_nop 0\n\tglobal_load_lds_dwordx4 %1, off\n\ts_mov_b32 m0, %0" : "=&s"(keep) : "v"(gsrc), "s"(lds_dst) : "memory"); }
typedef unsigned u32x2 __attribute__((ext_vector_type(2)));
__device__ __forceinline__ u32x2 gload8(const void* p) { u32x2 r; asm volatile("global_load_dwordx2 %0, %1, off" : "=v"(r) : "v"(p) : "memory"); return r; }
__device__ __forceinline__ unsigned atom_add_untracked(unsigned* p, unsigned v) { unsigned r; asm volatile("global_atomic_add %0, %1, %2, off sc0" : "=v"(r) : "v"(p), "v"(v) : "memory"); return r; }
__device__ __forceinline__ u32x4 gload16(const void* p) { u32x4 r; asm volatile("global_load_dwordx4 %0, %1, off" : "=v"(r) : "v"(p) : "memory"); return r; }
__device__ __forceinline__ float max3f(float a, float b, float c) { float r; asm("v_max3_f32 %0, %1, %2, %3" : "=v"(r) : "v"(a), "v"(b), "v"(c)); return r; }
__device__ __forceinline__ float rowmax32(const f32x16& p0, const f32x16& p1) {
    float a = max3f(p0[0], p0[1], p1[0]), b = max3f(p0[2], p0[3], p1[1]); a = max3f(a, p1[2], p1[3]);
#pragma unroll
    for (int r = 4; r < 16; r += 4) { a = max3f(a, p0[r], p0[r + 1]); b = max3f(b, p0[r + 2], p0[r + 3]); a = max3f(a, p1[r], p1[r + 1]); b = max3f(b, p1[r + 2], p1[r + 3]); }
    float m = fmaxf(a, b);
    return fmaxf(m, __shfl_xor(m, 32));
}
template <int ABL, bool HASNEXT = false>
__device__ __forceinline__ void attn_unit_b(const Bufs& B, int b, int h, int qt, ATT_LAS unsigned char* lds, unsigned* ctr, volatile ATT_LAS unsigned* uw, bool pf, bool pre = false) {
    constexpr int NKS = 6, KROWB = 208, NT = 33;
    int tid_ = threadIdx.x; asm volatile("" : "+v"(tid_));
    const int tid = tid_, lane = tid & 63, r32 = lane & 31, hi = lane >> 5, wid = __builtin_amdgcn_readfirstlane(tid >> 6);
    const int Pw = (qt < 8 ? 16 + 256 * qt : -16) + 32 * wid, P = Pw + r32, Pc = P < 0 ? 0 : (P < LTOK ? P : LTOK - 1);
    const bool wave_valid = (ABL == 6) ? false : (qt < 8 || wid == 0);
    const size_t rb = (size_t)b * LTOK, rowq = rb + Pc;
    const unsigned lds0 = (unsigned)(uintptr_t)lds;
#define B_SRC(LN_, WD_, RB_, HH_, K1_, K2_, V1_) do { \
        const int c1 = 64 * (WD_) + (LN_), kkey1 = c1 / 13, kcol1 = c1 % 13; \
        const int c2 = 64 * ((WD_) + 8) + (LN_), kkey2 = (c2 / 13) & 63, kcol2 = c2 % 13;          \
        const int vkey = 8 * (WD_) + ((LN_) >> 3), vcs = ((LN_) & 7) ^ (((vkey >> 1) & 1) << 2); \
        const bf16_t* knb = B.KNB() + (RB_) * 512 + (HH_) * 64; const bf16_t* ckr = B.CQX() + (RB_) * 512 + 256 + 128; \
        K1_ = kcol1 < 8 ? (const char*)(knb + (size_t)kkey1 * 512 + kcol1 * 8) : (const char*)(ckr + (size_t)kkey1 * 512 + ((kcol1 - 8) & 3) * 8); \
        const char* ks2 = kcol2 < 8 ? (const char*)(knb + (size_t)kkey2 * 512 + kcol2 * 8) : (const char*)(ckr + (size_t)kkey2 * 512 + ((kcol2 - 8) & 3) * 8); \
        K2_ = (WD_) < 5 ? ks2 : K1_;                           \
        V1_ = (const char*)(B.VB() + (RB_) * 512 + (HH_) * 64 + vcs * 8 + (size_t)vkey * 512); \
    } while (0)
    const char* ks1; const char* ks2x; const char* vs1;
    B_SRC(lane, wid, rb, h, ks1, ks2x, vs1);
#define B_GLDS(src, off) glds16((src), (unsigned)__builtin_amdgcn_readfirstlane((int)(lds0 + (unsigned)(off))))
#define DMA_K1(kt) B_GLDS(ks1 + (size_t)(kt) * 65536u, B_KRING + ((kt) % B_NSK) * B_KSLOT + wid * 1024)
#define DMA_K2(kt) B_GLDS(ks2x + (size_t)(kt) * 65536u, wid < 5 ? B_KRING + ((kt) % B_NSK) * B_KSLOT + (wid + 8) * 1024 : B_DUMP + wid * 1024)
#define DMA_V(kt)  B_GLDS(vs1 + (size_t)(kt) * 65536u, B_VRING + ((kt) % B_NSV) * 8192 + wid * 1024)
#define B_WAITBAR(N) do { asm volatile("s_waitcnt vmcnt(" #N ") lgkmcnt(0)" ::: "memory"); __builtin_amdgcn_s_barrier(); asm volatile("" ::: "memory"); } while (0)
    if (!pre) { DMA_K1(0); DMA_K2(0); DMA_V(0); DMA_K1(1); DMA_K2(1); DMA_V(1); DMA_K1(2); DMA_K2(2); }
    bf16x8 qf[NKS];
#pragma unroll
    for (int ks = 0; ks < NKS; ++ks) {
        const int blk = (Pw + QB_SHIFT) >> 5;
        const bf16_t* qp = (ks < 4) ? B.QBN() + qfrag_blk(b, blk, h, ks, hi, 4) + r32 * 8 : B.QBR() + qfrag_blk(b, blk, h, ks - 4, hi, 2) + r32 * 8;
        qf[ks] = *(const bf16x8*)qp;
    }
    asm volatile("" : "+v"(qf[0]), "+v"(qf[1]), "+v"(qf[2]), "+v"(qf[3]), "+v"(qf[4]), "+v"(qf[5]));
    const int q4 = (lane & 15) >> 2, p4 = lane & 3, g1 = (lane >> 4) & 1, swz = (q4 >> 1) & 1;
    const int vrd0 = (4 * hi + q4) * 128 + 32 * g1 + 8 * p4 + 64 * swz, vrd1 = (4 * hi + q4) * 128 + 32 * g1 + 8 * p4 + 64 * (1 - swz);
    const int krd = r32 * KROWB + hi * 16;
    ATT_LAS float* wsf = (ATT_LAS float*)(lds + B_WSF) + wid * 64;
    B_WAITBAR(6);
    float mhat = 0.f;
    f32x16 o0, o1, c0, c1v, lacc, negm;
#pragma unroll
    for (int r = 0; r < 16; ++r) { o0[r] = 0.f; o1[r] = 0.f; c0[r] = 0.f; c1v[r] = 0.f; lacc[r] = 0.f; negm[r] = 0.f; }
    const bf16x8 ones = (bf16x8){0x3f80, 0x3f80, 0x3f80, 0x3f80, 0x3f80, 0x3f80, 0x3f80, 0x3f80};
    if (wave_valid) {
        ATT_LAS const unsigned char* kb_ = lds + B_KRING + krd;
#pragma unroll
        for (int ks = 0; ks < NKS; ++ks) {
            const bf16x8 k0_ = *(ATT_LAS const bf16x8*)(kb_ + ks * 32), k1_ = *(ATT_LAS const bf16x8*)(kb_ + 32 * KROWB + ks * 32);
            c0 = __builtin_amdgcn_mfma_f32_32x32x16_bf16(k0_, qf[ks], c0, 0, 0, 0); c1v = __builtin_amdgcn_mfma_f32_32x32x16_bf16(k1_, qf[ks], c1v, 0, 0, 0);
        }
        asm volatile("s_nop 15\n\ts_nop 7" : "+v"(c0), "+v"(c1v));
        const float tmax = rowmax32(c0, c1v);
        mhat = tmax;
#pragma unroll
        for (int r = 0; r < 16; ++r) { c0[r] -= mhat; c1v[r] -= mhat; negm[r] = -mhat; }
    }
    asm volatile("" : "+v"(negm));
    B_WAITBAR(0);
#define SB() __builtin_amdgcn_sched_barrier(0)
#define EXP2(x) x = __builtin_amdgcn_exp2f(x)
#define B_KREADH(ks) do { kf[2 * (ks)] = *(ATT_LAS const bf16x8*)(kb_ + (ks) * 32); } while (0)
#define B_KREAD(ks) do { kf[2 * (ks)] = *(ATT_LAS const bf16x8*)(kb_ + (ks) * 32); kf[2 * (ks) + 1] = *(ATT_LAS const bf16x8*)(kb_ + 32 * KROWB + (ks) * 32); } while (0)
#define VRD(i) va[i] = vtr(vb + (((i) & 2) ? vrd1 : vrd0) + ((i) >> 2) * 2048 + ((i) & 1) * 1024)
#define PWG(g, C, base) pw[g] = (u32x4){cvtpk(C[base], C[base + 1]), cvtpk(C[base + 2], C[base + 3]), cvtpk(C[base + 4], C[base + 5]), cvtpk(C[base + 6], C[base + 7])}
#define VF0(ks) (bf16x8){va[4 * (ks)][0], va[4 * (ks)][1], va[4 * (ks)][2], va[4 * (ks)][3], va[4 * (ks) + 1][0], va[4 * (ks) + 1][1], va[4 * (ks) + 1][2], va[4 * (ks) + 1][3]}
#define VF1(ks) (bf16x8){va[4 * (ks) + 2][0], va[4 * (ks) + 2][1], va[4 * (ks) + 2][2], va[4 * (ks) + 2][3], va[4 * (ks) + 3][0], va[4 * (ks) + 3][1], va[4 * (ks) + 3][2], va[4 * (ks) + 3][3]}
#define QK0(ks) n0 = __builtin_amdgcn_mfma_f32_32x32x16_bf16(kf[2 * (ks)], qf[ks], n0, 0, 0, 0)
#define QK1(ks) n1 = __builtin_amdgcn_mfma_f32_32x32x16_bf16(kf[2 * (ks) + 1], qf[ks], n1, 0, 0, 0)
#define PVO0(ks) o0 = __builtin_amdgcn_mfma_f32_32x32x16_bf16(VF0(ks), __builtin_bit_cast(bf16x8, pw[ks]), o0, 0, 0, 0)
#define PVO1(ks) o1 = __builtin_amdgcn_mfma_f32_32x32x16_bf16(VF1(ks), __builtin_bit_cast(bf16x8, pw[ks]), o1, 0, 0, 0)
#define PVL(ks)  lacc = __builtin_amdgcn_mfma_f32_32x32x16_bf16(ones, __builtin_bit_cast(bf16x8, pw[ks]), lacc, 0, 0, 0)
#define MX3(P, lo) a_ = max3f(a_, P[lo], P[lo + 1]); b_ = max3f(b_, P[lo + 2], P[lo + 3])
#define B_ITER(T, QKF, ISSM, MSKF, ENDW, CI0, CI1, CO0, CO1, HQ, LP) do { \
        if (wave_valid) { \
            bf16x8 kf[2 * NKS]; s16x4 va[16]; u32x4 pw[4]; float a_ = 0.f, b_ = 0.f, tmax_ = 0.f; \
            ATT_LAS const unsigned char* kb_ = lds + B_KRING + (((T) + 1) % B_NSK) * B_KSLOT + krd; \
            ATT_LAS const unsigned char* vb = lds + B_VRING + ((T) % B_NSV) * 8192; \
            if (QKF) { if (HQ) { B_KREADH(0); B_KREADH(1); B_KREADH(2); } else { B_KREAD(0); B_KREAD(1); B_KREAD(2); } } \
            VRD(0); VRD(1); VRD(2); VRD(3); \
            EXP2(CI0[0]); EXP2(CI0[1]); EXP2(CI0[2]); EXP2(CI0[3]); EXP2(CI0[4]); EXP2(CI0[5]); EXP2(CI0[6]); EXP2(CI0[7]); PWG(0, CI0, 0); \
            SB(); \
            if (QKF) CO0 = __builtin_amdgcn_mfma_f32_32x32x16_bf16(kf[0], qf[0], negm, 0, 0, 0); \
            if (QKF) { if (HQ) B_KREADH(3); else B_KREAD(3); } if (!(LP)) VRD(4); if (!(LP)) EXP2(CI0[8]); if (!(LP)) EXP2(CI0[9]); SB(); \
            if (QKF && !(HQ)) CO1 = __builtin_amdgcn_mfma_f32_32x32x16_bf16(kf[1], qf[0], negm, 0, 0, 0); \
            if (!(LP)) VRD(5); if (!(LP)) EXP2(CI0[10]); if (!(LP)) EXP2(CI0[11]); SB(); \
            if (QKF) CO0 = __builtin_amdgcn_mfma_f32_32x32x16_bf16(kf[2], qf[1], CO0, 0, 0, 0); \
            if (QKF) { if (HQ) B_KREADH(4); else B_KREAD(4); } if (!(LP)) VRD(6); if (!(LP)) EXP2(CI0[12]); if (!(LP)) EXP2(CI0[13]); SB(); \
            if (QKF && !(HQ)) CO1 = __builtin_amdgcn_mfma_f32_32x32x16_bf16(kf[3], qf[1], CO1, 0, 0, 0); \
            if (!(LP)) VRD(7); if (!(LP)) EXP2(CI0[14]); if (!(LP)) EXP2(CI0[15]); SB(); \
            if (QKF) CO0 = __builtin_amdgcn_mfma_f32_32x32x16_bf16(kf[4], qf[2], CO0, 0, 0, 0); \
            if (QKF) { if (HQ) B_KREADH(5); else B_KREAD(5); } if (!(LP)) VRD(8); if (!(LP)) PWG(1, CI0, 8); SB(); \
            if (QKF && !(HQ)) CO1 = __builtin_amdgcn_mfma_f32_32x32x16_bf16(kf[5], qf[2], CO1, 0, 0, 0); \
            if (!(LP)) VRD(9); if (!(LP)) EXP2(CI1[0]); if (!(LP)) EXP2(CI1[1]); SB(); \
            if (QKF) CO0 = __builtin_amdgcn_mfma_f32_32x32x16_bf16(kf[6], qf[3], CO0, 0, 0, 0); \
            if (!(LP)) VRD(10); if (!(LP)) EXP2(CI1[2]); if (!(LP)) EXP2(CI1[3]); SB(); \
            if (QKF && !(HQ)) CO1 = __builtin_amdgcn_mfma_f32_32x32x16_bf16(kf[7], qf[3], CO1, 0, 0, 0); \
            if (!(LP)) VRD(11); if (!(LP)) EXP2(CI1[4]); if (!(LP)) EXP2(CI1[5]); SB(); \
            if (QKF) CO0 = __builtin_amdgcn_mfma_f32_32x32x16_bf16(kf[8], qf[4], CO0, 0, 0, 0); \
            if (!(LP)) VRD(12); if (!(LP)) EXP2(CI1[6]); if (!(LP)) EXP2(CI1[7]); SB(); \
            if (QKF && !(HQ)) CO1 = __builtin_amdgcn_mfma_f32_32x32x16_bf16(kf[9], qf[4], CO1, 0, 0, 0); \
            if (!(LP)) VRD(13); if (!(LP)) PWG(2, CI1, 0); SB(); \
            if (QKF) CO0 = __builtin_amdgcn_mfma_f32_32x32x16_bf16(kf[10], qf[5], CO0, 0, 0, 0); \
            if (!(LP)) VRD(14); if (!(LP)) EXP2(CI1[8]); if (!(LP)) EXP2(CI1[9]); SB(); \
            if (QKF && !(HQ)) CO1 = __builtin_amdgcn_mfma_f32_32x32x16_bf16(kf[11], qf[5], CO1, 0, 0, 0); \
            if (!(LP)) VRD(15); if (!(LP)) EXP2(CI1[10]); if (!(LP)) EXP2(CI1[11]); SB(); \
            PVO0(0); if (!(LP)) EXP2(CI1[12]); if (!(LP)) EXP2(CI1[13]); SB(); \
            PVO1(0); if (!(LP)) EXP2(CI1[14]); if (!(LP)) EXP2(CI1[15]); SB(); \
            PVL(0);  if (ISSM == 1) DMA_K1((T) + 3); SB(); \
            if (!(LP)) PVO0(1); if (!(LP)) PWG(3, CI1, 8); SB(); \
            if (!(LP)) PVO1(1); if (ISSM == 1) DMA_K2((T) + 3); SB(); \
            if (!(LP)) PVL(1);  if (ISSM >= 1) DMA_V((T) + 2); \
                     if (MSKF) { _Pragma("unroll") for (int r = 0; r < 16; ++r) { if (r >= 8) CO0[r] = -INFINITY; CO1[r] = -INFINITY; } } SB(); \
            if (!(LP)) PVO0(2); if (QKF) { a_ = max3f(CO0[0], CO0[1], CO1[0]); b_ = max3f(CO0[2], CO0[3], CO1[1]); a_ = max3f(a_, CO1[2], CO1[3]); } SB(); \
            if (!(LP)) PVO1(2); if (QKF) { MX3(CO0, 4); MX3(CO1, 4); } SB(); \
            if (!(LP)) PVL(2);  if (QKF) { MX3(CO0, 8); MX3(CO1, 8); } if (ISSM == 1) DMA_K1((T) + 4); SB(); \
            if (!(LP)) PVO0(3); if (QKF) { MX3(CO0, 12); MX3(CO1, 12); } SB(); \
            if (!(LP)) PVO1(3); if (QKF) { tmax_ = fmaxf(a_, b_); tmax_ = fmaxf(tmax_, __shfl_xor(tmax_, 32)); } if (ISSM == 1) DMA_K2((T) + 4); SB(); \
            if (!(LP)) PVL(3);  if (ISSM == 1) DMA_V((T) + 3); SB(); \
            if (QKF) { \
                if (__any(tmax_ > THR)) { \
                    const float dl = fmaxf(tmax_, 0.f), f = __builtin_amdgcn_exp2f(-dl); \
                    mhat += dl; \
                    _Pragma("unroll") for (int r = 0; r < 16; ++r) { CO0[r] -= dl; CO1[r] -= dl; negm[r] = -mhat; } \
                    asm volatile("" : "+v"(negm)); \
                    _Pragma("unroll") for (int r = 0; r < 16; ++r) { o0[r] *= f; o1[r] *= f; lacc[r] *= f; } \
                } \
            } \
        } else { \
            if (ISSM == 1) { DMA_K1((T) + 3); DMA_K2((T) + 3); DMA_V((T) + 2); DMA_K1((T) + 4); DMA_K2((T) + 4); DMA_V((T) + 3); } else if (ISSM == 2) DMA_V((T) + 2); \
        } \
        SB(); \
        ENDW; \
    } while (0)
    unsigned nxt = 0; u32x4 gp[4];
    {
        f32x16 n0, n1;
#pragma unroll
        for (int r = 0; r < 16; ++r) { n0[r] = 0.f; n1[r] = 0.f; }
        static_assert(NT == 33, "tile-loop unrolling below assumes 33 tiles");
#pragma unroll 1
        for (int t = 0; t <= 28; t += 2) { B_ITER(t, true, 1, false, asm volatile("" ::: "memory"), c0, c1v, n0, n1, false, false); B_ITER(t + 1, true, 0, false, B_WAITBAR(0), n0, n1, c0, c1v, false, false); }
        B_ITER(30, true, 2, false, asm volatile("" ::: "memory"), c0, c1v, n0, n1, false, false);
        B_ITER(31, true, 0, true, B_WAITBAR(0), n0, n1, c0, c1v, true, false);
        if (pf && tid == 0) nxt = atom_add_untracked(ctr, 1u);
#pragma unroll
        for (int i = 0; i < 4; ++i) { const int Pg = Pw + i * 8 + (lane >> 3);
            gp[i] = gload16(B.GBS() + (rb + (Pg < 0 ? 0 : (Pg < LTOK ? Pg : LTOK - 1))) * 512 + h * 64 + (lane & 7) * 8); }
        B_ITER(32, false, 0, false, asm volatile("" ::: "memory"), c0, c1v, n0, n1, false, true);
    }
    if (HASNEXT) {
        asm volatile("s_waitcnt lgkmcnt(0)" ::: "memory"); __builtin_amdgcn_s_barrier(); asm volatile("" ::: "memory");
        const char* nk1; const char* nk2; const char* nv1;
        const int nbh = b * 8 + h + 32;
        int ln2 = lane, wd2 = wid; asm volatile("" : "+v"(ln2), "+s"(wd2));
        B_SRC(ln2, wd2, (size_t)(nbh >> 3) * LTOK, (nbh & 7), nk1, nk2, nv1);
#define N_K1(kt) B_GLDS(nk1 + (size_t)(kt) * 65536u, B_KRING + ((kt) % B_NSK) * B_KSLOT + wid * 1024)
#define N_K2(kt) B_GLDS(nk2 + (size_t)(kt) * 65536u, wid < 5 ? B_KRING + ((kt) % B_NSK) * B_KSLOT + (wid + 8) * 1024 : B_DUMP + wid * 1024)
#define N_V(kt)  B_GLDS(nv1 + (size_t)(kt) * 65536u, B_VRING + ((kt) % B_NSV) * 8192 + wid * 1024)
        N_K1(0); N_K2(0); N_V(0); N_K1(1); N_K2(1); N_V(1); N_K1(2); N_K2(2);
#undef N_K1
#undef N_K2
#undef N_V
    }
#undef B_ITER
#undef MX3
#undef SB
#undef EXP2
#undef VRD
#undef PWG
#undef VF0
#undef VF1
#undef QK0
#undef QK1
#undef PVO0
#undef PVO1
#undef PVL
    if (HASNEXT) asm volatile("s_waitcnt vmcnt(8)" : "+v"(nxt), "+v"(gp[0]), "+v"(gp[1]), "+v"(gp[2]), "+v"(gp[3]) :: "memory");
    else asm volatile("s_waitcnt vmcnt(0)" : "+v"(nxt), "+v"(gp[0]), "+v"(gp[1]), "+v"(gp[2]), "+v"(gp[3]) :: "memory");
    if (wave_valid) {
        const float inv = __builtin_amdgcn_rcpf(lacc[0]); float ss = 0.f;
        ATT_LAS unsigned char* stg = lds + B_OST + wid * 4096;
        const int sw = (r32 ^ (r32 >> 3)) & 7;
#pragma unroll
        for (int i = 0; i < 8; ++i) {
            const int k = i & 3;
            const float v0 = (i < 4 ? o0[4 * k] : o1[4 * k]) * inv, v1 = (i < 4 ? o0[4 * k + 1] : o1[4 * k + 1]) * inv, v2 = (i < 4 ? o0[4 * k + 2] : o1[4 * k + 2]) * inv, v3 = (i < 4 ? o0[4 * k + 3] : o1[4 * k + 3]) * inv;
            ss += v0 * v0 + v1 * v1 + v2 * v2 + v3 * v3;
            *(ATT_LAS u32x2*)(stg + r32 * 128 + ((i ^ sw) << 4) + 8 * hi) = (u32x2){cvtpk(v0, v1), cvtpk(v2, v3)};
        }
        ss += __shfl_xor(ss, 32);
        if ((unsigned)P < (unsigned)LTOK && hi == 0) { float* sq = ABL ? (float*)(B.ws + WS_END + (size_t)MPAD * 2048) : B.ssqy(); sq[(size_t)((8 + h) * 2) * MROWS + rowq] = ss; sq[(size_t)((8 + h) * 2 + 1) * MROWS + rowq] = 0.f; }
        bf16_t* Yb = (ABL ? (bf16_t*)(B.ws + WS_END) : B.Y()) + 512 + h * 64 + (lane & 7) * 8;
#pragma unroll
        for (int i = 0; i < 4; ++i) {
            const int row = i * 8 + (lane >> 3), Pr = Pw + row;
            const u32x4 ov = *(ATT_LAS const u32x4*)(stg + row * 128 + (((lane & 7) ^ ((row ^ (row >> 3)) & 7)) << 4));
            const unsigned ou[4] = {ov.x, ov.y, ov.z, ov.w}, gu[4] = {gp[i].x, gp[i].y, gp[i].z, gp[i].w}; unsigned yw[4];
#pragma unroll
            for (int j = 0; j < 4; ++j) yw[j] = cvtpk(__uint_as_float(ou[j] << 16) * __uint_as_float(gu[j] << 16), __uint_as_float(ou[j] & 0xffff0000u) * __uint_as_float(gu[j] & 0xffff0000u));
            if ((unsigned)Pr < (unsigned)LTOK) *(u32x4*)(Yb + (rb + Pr) * 1024) = (u32x4){yw[0], yw[1], yw[2], yw[3]};
        }
    }
    if (pf && tid == 0) *uw = nxt;
    __syncthreads();
#undef B_VREAD
#undef B_KREAD
#undef B_KREADH
#undef B_GLDS
#undef B_SRC
#undef DMA_K1
#undef DMA_K2
#undef DMA_V
#undef B_WAITBAR
}


constexpr int A_KB = 0, A_KROW = 144, A_VB = A_KB + 384 * A_KROW, A_KM = A_VB + 384 * 128, A_VM = A_KM + 5 * 1024, A_TM = A_VM + 32 * 128, A_TR = A_TM + 4 * 1280, A_STG = A_TR + 4 * 1280, A_END = A_STG + 8 * 2048;
static_assert(A_END <= 143360, "A unit LDS map");
template <int ABL = 0>
__device__ __forceinline__ void attn_unit_a2(const Params& p, const Bufs& B, int layer, int b, int g, int qb, ATT_LAS unsigned char* lds, unsigned* ctr, volatile ATT_LAS unsigned* uw) {
    int tid_ = threadIdx.x; asm volatile("" : "+v"(tid_));
    const int tid = tid_, lane = tid & 63, r32 = lane & 31, hi = lane >> 5, wid = __builtin_amdgcn_readfirstlane(tid >> 6);
    const int hh = wid & 3, half = wid >> 2, h = 4 * g + hh;
    const size_t rb = (size_t)b * LTOK;
    const unsigned lds0 = (unsigned)(uintptr_t)lds;
    const int kbase = 128 * qb - 128;
    if (ABL == 12) { __syncthreads(); if (tid == 0) *uw = atomicAdd(ctr, 1u); __syncthreads(); return; }
    {
        const bf16_t* ka = B.KA() + rb * 128 + g * 64; const bf16_t* va_ = B.VA() + rb * 128 + g * 64;
        for (int pc = wid; pc < 54; pc += 8) { const int c = 64 * pc + lane, row = c / 9, col = c % 9; int kp = kbase + row; kp = kp < 0 ? 0 : (kp > LTOK - 1 ? LTOK - 1 : kp);
            glds16(ka + (size_t)kp * 128 + (col & 7) * 8, (unsigned)__builtin_amdgcn_readfirstlane((int)(lds0 + A_KB + pc * 1024))); }
        for (int pc = wid; pc < 48; pc += 8) { const int c = 64 * pc + lane, row = c >> 3, cs = (c & 7) ^ (((row >> 1) & 1) << 2); int kp = kbase + row; kp = kp < 0 ? 0 : (kp > LTOK - 1 ? LTOK - 1 : kp);
            glds16(va_ + (size_t)kp * 128 + cs * 8, (unsigned)__builtin_amdgcn_readfirstlane((int)(lds0 + A_VB + pc * 1024))); }
        if (wid < 5) { const int c = 64 * wid + lane, row = (c / 9) & 31, col = c % 9;
            glds16(ka + (size_t)row * 128 + (col & 7) * 8, (unsigned)__builtin_amdgcn_readfirstlane((int)(lds0 + A_KM + wid * 1024))); }
        else if (wid < 7) { const int pc = wid - 5; const int c = 64 * pc + lane, row = c >> 3, cs = (c & 7) ^ (((row >> 1) & 1) << 2);
            glds16(va_ + (size_t)row * 128 + cs * 8, (unsigned)__builtin_amdgcn_readfirstlane((int)(lds0 + A_VM + pc * 1024))); }
    }
    {
        const char* tsrc = (const char*)(B.ws + OFF_A2T) + (size_t)g * 10240 + lane * 16;
        glds16(tsrc + wid * 1024, (unsigned)__builtin_amdgcn_readfirstlane((int)(lds0 + A_TM + wid * 1024)));
        if (wid < 2) glds16(tsrc + (wid + 8) * 1024, (unsigned)__builtin_amdgcn_readfirstlane((int)(lds0 + A_TM + (wid + 8) * 1024)));
    }
    u32x4 qf_[4];
    { const int P0 = 128 * qb + 64 * half + r32, Pc0 = P0 < LTOK ? P0 : LTOK - 1;
#pragma unroll
      for (int ks = 0; ks < 4; ++ks) qf_[ks] = gload16(B.QA() + qfrag_blk(b, (P0 < LTOK ? P0 : LTOK - 1) >> 5, h, ks, hi, 4) + r32 * 8); }
    asm volatile("s_waitcnt vmcnt(0) lgkmcnt(0)" : "+v"(qf_[0]), "+v"(qf_[1]), "+v"(qf_[2]), "+v"(qf_[3]) :: "memory"); __builtin_amdgcn_s_barrier(); asm volatile("" ::: "memory");
    unsigned nxt = 0;
    const float sink2 = p.sink[layer * 8 + h] * LOG2E;
    const int q4 = (lane & 15) >> 2, p4 = lane & 3, g1 = (lane >> 4) & 1, swz = (q4 >> 1) & 1;
    const int vrd0 = (4 * hi + q4) * 128 + 32 * g1 + 8 * p4 + 64 * swz, vrd1 = (4 * hi + q4) * 128 + 32 * g1 + 8 * p4 + 64 * (1 - swz);
    const int krd = r32 * A_KROW + hi * 16;
    ATT_LAS const float* tmh = (ATT_LAS const float*)(lds + A_TM) + hh * 320; ATT_LAS const float* trh = (ATT_LAS const float*)(lds + A_TR) + hh * 320;
    ATT_LAS float* wsf = (ATT_LAS float*)(lds + A_STG + wid * 2048);
    const bf16x8 ones = (bf16x8){0x3f80, 0x3f80, 0x3f80, 0x3f80, 0x3f80, 0x3f80, 0x3f80, 0x3f80};
#pragma unroll
    for (int sbi = 0; sbi < (ABL == 11 ? 0 : 2); ++sbi) {
        const int sb = 2 * half + sbi, Pw = 128 * qb + 32 * sb;
        if (Pw >= LTOK) break;
        const int P = Pw + r32, Pc = P < LTOK ? P : LTOK - 1;
        const bf16x8 qf[4] = {__builtin_bit_cast(bf16x8, qf_[0]), __builtin_bit_cast(bf16x8, qf_[1]), __builtin_bit_cast(bf16x8, qf_[2]), __builtin_bit_cast(bf16x8, qf_[3])};
        u32x4 qn[4] = {qf_[0], qf_[1], qf_[2], qf_[3]}; u32x4 gp[4];
        const bool ok = P < LTOK; const size_t grow = rb + Pc;
        {
#pragma unroll
            for (int i = 0; i < 4; ++i) { const int Pg = Pw + (i & 1) * 16 + (lane >> 2);
                gp[i] = gload16(B.GAS() + (rb + (Pg < LTOK ? Pg : LTOK - 1)) * 512 + h * 64 + (i >> 1) * 32 + (lane & 3) * 8); }
            if (sbi == 0) { const int Pn = P + 32, Pnc = Pn < LTOK ? Pn : LTOK - 1;
#pragma unroll
                for (int ks = 0; ks < 4; ++ks) qn[ks] = gload16(B.QA() + qfrag_blk(b, Pnc >> 5, h, ks, hi, 4) + r32 * 8);
                if (tid == 0) nxt = atom_add_untracked(ctr, 1u); }
        }
        f32x16 o0, o1, lacc, negm;
#pragma unroll
        for (int r = 0; r < 16; ++r) { o0[r] = 0.f; o1[r] = 0.f; lacc[r] = 1.0f; negm[r] = -sink2; }
        asm volatile("" : "+v"(negm));
        float mhat = sink2;
#define A_SOFTPV(c, vbase, NKV) do { \
            float a_ = max3f(c[0], c[1], c[2]), b_ = max3f(c[3], c[4], c[5]); a_ = max3f(a_, c[6], c[7]); b_ = max3f(b_, c[8], c[9]); a_ = max3f(a_, c[10], c[11]); b_ = max3f(b_, c[12], c[13]); a_ = max3f(a_, c[14], c[15]); \
            float tmax = fmaxf(a_, b_); tmax = fmaxf(tmax, __shfl_xor(tmax, 32)); \
            if (__any(tmax > THR)) { const float dl = fmaxf(tmax, 0.f), f = __builtin_amdgcn_exp2f(-dl); mhat += dl; \
                _Pragma("unroll") for (int r = 0; r < 16; ++r) { c[r] -= dl; negm[r] = -mhat; } asm volatile("" : "+v"(negm)); \
                _Pragma("unroll") for (int r = 0; r < 16; ++r) { o0[r] *= f; o1[r] *= f; lacc[r] *= f; } } \
            _Pragma("unroll") for (int r = 0; r < 16; ++r) c[r] = __builtin_amdgcn_exp2f(c[r]); \
            _Pragma("unroll") for (int ks = 0; ks < NKV; ++ks) { \
                const bf16x8 pa = __builtin_bit_cast(bf16x8, (u32x4){cvtpk(c[8 * ks], c[8 * ks + 1]), cvtpk(c[8 * ks + 2], c[8 * ks + 3]), cvtpk(c[8 * ks + 4], c[8 * ks + 5]), cvtpk(c[8 * ks + 6], c[8 * ks + 7])}); \
                const s16x4 a0 = vtr((vbase) + vrd0 + ks * 2048), a1 = vtr((vbase) + vrd0 + ks * 2048 + 1024), e0 = vtr((vbase) + vrd1 + ks * 2048), e1 = vtr((vbase) + vrd1 + ks * 2048 + 1024); \
                const bf16x8 vf0 = (bf16x8){a0[0], a0[1], a0[2], a0[3], a1[0], a1[1], a1[2], a1[3]}, vf1 = (bf16x8){e0[0], e0[1], e0[2], e0[3], e1[0], e1[1], e1[2], e1[3]}; \
                o0 = __builtin_amdgcn_mfma_f32_32x32x16_bf16(vf0, pa, o0, 0, 0, 0); o1 = __builtin_amdgcn_mfma_f32_32x32x16_bf16(vf1, pa, o1, 0, 0, 0); \
                lacc = __builtin_amdgcn_mfma_f32_32x32x16_bf16(ones, pa, lacc, 0, 0, 0); } } while (0)
        {
            ATT_LAS const unsigned char* kb = lds + A_KM + krd;
            f32x16 c = __builtin_amdgcn_mfma_f32_32x32x16_bf16(*(ATT_LAS const bf16x8*)(kb), qf[0], negm, 0, 0, 0);
#pragma unroll
            for (int ks = 1; ks < 4; ++ks) c = __builtin_amdgcn_mfma_f32_32x32x16_bf16(*(ATT_LAS const bf16x8*)(kb + ks * 32), qf[ks], c, 0, 0, 0);
            const int d0 = 4 * hi - Pc;
#pragma unroll
            for (int r = 0; r < 16; ++r) { if (r < 8) { int ix = d0 + crow(r, 0) + 160; ix = ix < 0 ? 0 : ix; c[r] += trh[ix]; } else c[r] = -INFINITY; }
            A_SOFTPV(c, lds + A_VM, 1);
        }
#pragma unroll 1
        for (int j = 0; j < ((ABL == 7 || ABL == 10) ? 0 : 9); ++j) {
            const int blo = Pw - 128 + 32 * j;
            if (blo + 31 < NMETA || blo >= LTOK) continue;
            const int brow = 32 * (sb + j);
            ATT_LAS const unsigned char* kb = lds + A_KB + brow * A_KROW + krd;
            f32x16 c = __builtin_amdgcn_mfma_f32_32x32x16_bf16(*(ATT_LAS const bf16x8*)(kb), qf[0], negm, 0, 0, 0);
#pragma unroll
            for (int ks = 1; ks < 4; ++ks) c = __builtin_amdgcn_mfma_f32_32x32x16_bf16(*(ATT_LAS const bf16x8*)(kb + ks * 32), qf[ks], c, 0, 0, 0);
            const int d0 = 32 * j - 128 + 4 * hi - r32;
            ATT_LAS const float* tp = tmh + (d0 + 160);
            if (blo < NMETA || blo + 31 >= LTOK) {
#pragma unroll
                for (int r = 0; r < 16; ++r) { const int pk = blo + 4 * hi + crow(r, 0); c[r] = (pk >= NMETA && pk < LTOK) ? c[r] + tp[crow(r, 0)] : -INFINITY; }
            } else {
#pragma unroll
                for (int r = 0; r < 16; ++r) c[r] += tp[crow(r, 0)];
            }
            A_SOFTPV(c, lds + A_VB + brow * 128, 2);
        }
#undef A_SOFTPV
        asm volatile("s_waitcnt vmcnt(0)" : "+v"(gp[0]), "+v"(gp[1]), "+v"(gp[2]), "+v"(gp[3]), "+v"(qn[0]), "+v"(qn[1]), "+v"(qn[2]), "+v"(qn[3]), "+v"(nxt) :: "memory");
        if (ABL == 10) { if (o0[0] + o1[3] + lacc[2] == 12345.f) wsf[lane] = o0[1]; } else {
            const float inv = __builtin_amdgcn_rcpf(lacc[0]); float ss = 0.f;
            ATT_LAS unsigned char* stg = (ATT_LAS unsigned char*)wsf;
            const int sw = (r32 >> 2) & 3;
            bf16_t* Yb = (ABL ? (bf16_t*)(B.ws + WS_END) : B.Y()) + h * 64 + (lane & 3) * 8;
#pragma unroll
            for (int db = 0; db < 2; ++db) {
#pragma unroll
                for (int k = 0; k < 4; ++k) {
                    const float v0 = (db == 0 ? o0[4 * k] : o1[4 * k]) * inv, v1 = (db == 0 ? o0[4 * k + 1] : o1[4 * k + 1]) * inv, v2 = (db == 0 ? o0[4 * k + 2] : o1[4 * k + 2]) * inv, v3 = (db == 0 ? o0[4 * k + 3] : o1[4 * k + 3]) * inv;
                    ss += v0 * v0 + v1 * v1 + v2 * v2 + v3 * v3;
                    *(ATT_LAS u32x2*)(stg + r32 * 64 + ((k ^ sw) << 4) + 8 * hi) = (u32x2){cvtpk(v0, v1), cvtpk(v2, v3)};
                }
#pragma unroll
                for (int j = 0; j < 2; ++j) {
                    const int row = j * 16 + (lane >> 2), Pr = Pw + row;
                    const u32x4 ov = *(ATT_LAS const u32x4*)(stg + row * 64 + (((lane & 3) ^ ((row >> 2) & 3)) << 4));
                    const u32x4 gv = gp[db * 2 + j];
                    const unsigned ou[4] = {ov.x, ov.y, ov.z, ov.w}, gu[4] = {gv.x, gv.y, gv.z, gv.w}; unsigned yw[4];
#pragma unroll
                    for (int e = 0; e < 4; ++e) yw[e] = cvtpk(__uint_as_float(ou[e] << 16) * __uint_as_float(gu[e] << 16), __uint_as_float(ou[e] & 0xffff0000u) * __uint_as_float(gu[e] & 0xffff0000u));
                    if (Pr < LTOK) *(u32x4*)(Yb + (rb + Pr) * 1024 + db * 32) = (u32x4){yw[0], yw[1], yw[2], yw[3]};
                }
            }
            ss += __shfl_xor(ss, 32);
            if (ok && hi == 0) { float* sq = ABL ? (float*)(B.ws + WS_END + (size_t)MPAD * 2048) : B.ssqy(); sq[(size_t)(h * 2) * MROWS + grow] = ss; sq[(size_t)(h * 2 + 1) * MROWS + grow] = 0.f; }
        }
#pragma unroll
        for (int ks = 0; ks < 4; ++ks) qf_[ks] = qn[ks];
    }
    if (tid == 0) *uw = nxt;
    __syncthreads();
}

template <int ABL = 0>
__device__ __forceinline__ void attn_phase(const Params& p, const Bufs& B, int layer, ATT_LAS unsigned char* lds, int cidx = 0, int only = -1) {
    unsigned* ctr = (unsigned*)(p.ws + OFF_CTL) + 64 * (layer + 2 * cidx);
    volatile ATT_LAS unsigned* uw = (volatile ATT_LAS unsigned*)(lds + UWORD);
    const bool stat = (gridDim.x == 256);
    const bool dead_meta = (layer == 1);
    const int nst = stat ? 4 : 0, ubase = stat ? (dead_meta ? 1152 : 1024) : 0;
    const int cx = blockIdx.x & 7, cj = blockIdx.x >> 3;
    if (!stat) { if (threadIdx.x == 0) *uw = atomicAdd(ctr, 1u); __syncthreads(); }
    for (int it = 0;; ++it) {
        unsigned u; bool pf;
        if (it < nst) { u = (unsigned)(((it * 32 + cx * 4 + (cj >> 3)) << 3) + (cj & 7)); pf = (it == nst - 1); }
        else { u = ubase + *uw; pf = true; if (u >= (unsigned)NUNITS) break; }
        const bool skip = ((u < 1152) ? (only == 0) : (only == 1)) || (dead_meta && u >= 1024 && u < 1152);
        if (skip) { __syncthreads(); if (pf && threadIdx.x == 0) *uw = atomicAdd(ctr, 1u); __syncthreads(); continue; }
        if (u < 1152) { const int bh = u < 1024 ? (int)(u >> 3) : (int)u - 1024, qt = u < 1024 ? (int)(u & 7) : 8;
            const bool st_ = (it < nst) && only < 0;
            if (st_ && it + 1 < nst) attn_unit_b<ABL, true>(B, bh >> 3, bh & 7, qt, lds, ctr, uw, pf, it > 0);
            else attn_unit_b<ABL, false>(B, bh >> 3, bh & 7, qt, lds, ctr, uw, pf, st_ && it > 0); }
        else { const int i = u - 1152; int bg, qb; if (i < 512) { bg = i >> 4; qb = i & 15; } else { bg = i - 512; qb = 16; }
            attn_unit_a2<ABL>(p, B, layer, bg >> 1, bg & 1, qb, lds, ctr, uw); }
    }
}
}

__device__ __forceinline__ void phase_final(const Params& p, const Bufs& B) {
    const int lane = threadIdx.x & 63, gw = blockIdx.x * 8 + (threadIdx.x >> 6), NGW = gridDim.x * 8;
    for (int i0 = gw * 4; i0 < NBATCH * SEQ; i0 += NGW * 4) {
        uint2 hv[4][4]; float rs[4];
#pragma unroll
        for (int q = 0; q < 4; ++q) {
            const int i = i0 + q, b = i / SEQ, sq = i % SEQ, r = b * LTOK + NMETA + sq;
#pragma unroll
            for (int j = 0; j < 4; ++j) hv[q][j] = *(const uint2*)(B.H() + (size_t)r * DM + j * 256 + lane * 4);
            rs[q] = row_rs16(B.ssqh(), r, 1.0f / 1024.0f);
        }
#pragma unroll
        for (int j = 0; j < 4; ++j) {
            const int c = j * 256 + lane * 4; const float4 g = *(const float4*)(p.norm_f + c);
#pragma unroll
            for (int q = 0; q < 4; ++q) {
                float4 o; o.x = __uint_as_float(hv[q][j].x << 16) * rs[q] * g.x; o.y = __uint_as_float(hv[q][j].x & 0xffff0000u) * rs[q] * g.y;
                o.z = __uint_as_float(hv[q][j].y << 16) * rs[q] * g.z; o.w = __uint_as_float(hv[q][j].y & 0xffff0000u) * rs[q] * g.w;
                __builtin_nontemporal_store((nt_f4){o.x, o.y, o.z, o.w}, (nt_f4*)(p.out + (size_t)(i0 + q) * DM + c));
            }
        }
    }
}

constexpr int LDS_BYTES = 147456;

#define XB_TMO      128
#define XB_XCNT(j)  (256  + 64 * (j))
#define XB_XSUB(j)  (1280 + 64 * (j))
#define XB_XGEN(j)  (2304 + 64 * (j))
#define XB_TOP      3328
#define XB_TOPGEN   3392
#define XCD_BAR_WORDS 3456
#define XB_SPIN_CAP (1u << 18)
#define XB_LAS __attribute__((address_space(3)))
constexpr int BAR_WORD0 = 2048;
constexpr int LDS_BAR_OFF = 147456 - 64;
__device__ __forceinline__ unsigned xb_ld(unsigned* p)              { return __hip_atomic_load(p, __ATOMIC_RELAXED, __HIP_MEMORY_SCOPE_AGENT); }
__device__ __forceinline__ unsigned xb_add(unsigned* p, unsigned v) { return __hip_atomic_fetch_add(p, v, __ATOMIC_RELAXED, __HIP_MEMORY_SCOPE_AGENT); }
__device__ __forceinline__ unsigned xb_xcc_id() { return (unsigned)__builtin_amdgcn_s_getreg((3 << 11) | 20) & 0xFu; }
#define XB_SPIN(cond, bar) do { unsigned _sp = 0; while (cond) { __builtin_amdgcn_s_sleep(1); \
    if ((++_sp & 255u) == 0u) { if (xb_ld(&(bar)[XB_TMO])) break; if (_sp > XB_SPIN_CAP) { atomicAdd(&(bar)[XB_TMO], 1u); break; } } } } while (0)
__device__ __forceinline__ void xcd_barrier_post(unsigned* bar) { if (threadIdx.x == 0) (void)xb_add(&bar[XB_XCNT(xb_xcc_id())], 1u); }
__device__ __forceinline__ void xcd_barrier_complete(unsigned* bar, unsigned x, unsigned& nloc, unsigned& nx) {
    const unsigned G = gridDim.x * gridDim.y * gridDim.z;
    unsigned sum, cnt, mine, sp = 0u;
    for (;;) {
        sum = 0u; cnt = 0u; mine = 0u;
#pragma unroll
        for (unsigned j = 0; j < 16; ++j) { const unsigned c = xb_ld(&bar[XB_XCNT(j)]); sum += c; cnt += (c > 0u) ? 1u : 0u; mine = (j == x) ? c : mine; }
        if (sum == G) break;
        __builtin_amdgcn_s_sleep(1);
        if ((++sp & 255u) == 0u) { if (xb_ld(&bar[XB_TMO])) break; if (sp > XB_SPIN_CAP) { atomicAdd(&bar[XB_TMO], 1u); break; } }
    }
    nloc = mine > 0u ? mine : 1u; nx = cnt > 0u ? cnt : 1u;
}
__device__ __forceinline__ void xcd_barrier(unsigned* bar, volatile XB_LAS unsigned* st) {
    asm volatile("s_waitcnt vmcnt(0)" ::: "memory");
    __syncthreads();
    if (threadIdx.x == 0) {
        const unsigned x = xb_xcc_id();
        __builtin_amdgcn_s_waitcnt(0);
        unsigned nloc = st[0], nx = st[1];
        if (nloc == 0u) { xcd_barrier_complete(bar, x, nloc, nx); st[0] = nloc; st[1] = nx; }
        const unsigned old = xb_add(&bar[XB_XSUB(x)], 1u);
        const unsigned gen = old / nloc;
        if (old + 1u == (gen + 1u) * nloc) {
            __builtin_amdgcn_fence(__ATOMIC_RELEASE, "agent");
            asm volatile("s_waitcnt vmcnt(0)" ::: "memory");
            const unsigned og = xb_add(&bar[XB_TOP], 1u);
            const unsigned tg = og / nx;
            if (og + 1u == (tg + 1u) * nx) xb_add(&bar[XB_TOPGEN], 1u);
            else XB_SPIN(xb_ld(&bar[XB_TOPGEN]) == tg, bar);
            __builtin_amdgcn_fence(__ATOMIC_ACQUIRE, "agent");
            xb_add(&bar[XB_XGEN(x)], 1u);
            asm volatile("s_waitcnt vmcnt(0)" ::: "memory");
        } else {
            XB_SPIN(xb_ld(&bar[XB_XGEN(x)]) == gen, bar);
            __builtin_amdgcn_fence(__ATOMIC_ACQUIRE, "agent");
            asm volatile("s_waitcnt vmcnt(0)" ::: "memory");
        }
    }
    __syncthreads();
}

typedef const __attribute__((address_space(4))) Params* kparams_t;
__device__ __forceinline__ Params load_params() {
    kparams_t q = (kparams_t)__builtin_amdgcn_kernarg_segment_ptr(); asm volatile("" : "+s"(q));
    Params r;
    r.x = q->x; r.meta = q->meta; r.relb = q->relb; r.norm_in = q->norm_in; r.w_in = q->w_in; r.sink = q->sink; r.norm_q = q->norm_q; r.w_uq = q->w_uq;
    r.norm_kv = q->norm_kv; r.w_ukv = q->w_ukv; r.norm_oa = q->norm_oa; r.norm_ob = q->norm_ob; r.w_out = q->w_out; r.norm_f = q->norm_f; r.out = q->out; r.ws = q->ws;
    return r;
}
#if USE_CG_SYNC
#define GRID_SYNC() cg::this_grid().sync()
#else
#define GRID_SYNC() do { const Params pb_ = load_params(); xcd_barrier((unsigned*)(pb_.ws + OFF_CTL) + BAR_WORD0, (volatile XB_LAS unsigned*)((XB_LAS unsigned char*)lds_raw + LDS_BAR_OFF)); } while (0)
#endif
template <int l>
__device__ __forceinline__ void run_layer(unsigned char* lds_raw) {
    float* ldsf = (float*)lds_raw; PG8_LAS unsigned char* ldsl = (PG8_LAS unsigned char*)lds_raw;
    { const Params p = load_params(); const Bufs B = make_bufs(p.ws); phase_inproj(ldsl, p, B, l); }
    GRID_SYNC();
#if PROBE_REP == 1
    { const Params p = load_params(); const Bufs B = make_bufs(p.ws); phase_inproj(ldsl, p, B, l); }
    GRID_SYNC();
#endif
    { const Params p = load_params(); const Bufs B = make_bufs(p.ws); phase_upproj(ldsl, B, l); }
    GRID_SYNC();
#if PROBE_REP == 2
    { const Params p = load_params(); const Bufs B = make_bufs(p.ws); phase_upproj(ldsl, B, l); }
    GRID_SYNC();
#endif
    { const Params p = load_params(); const Bufs B = make_bufs(p.ws); att::attn_phase(p, B, l, ldsl); }
    GRID_SYNC();
#if PROBE_REP == 3
    { const Params p = load_params(); const Bufs B = make_bufs(p.ws); att::attn_phase(p, B, l, ldsl, 1); }
    GRID_SYNC();
#endif
#if PROBE_REP == 5 || PROBE_REP == 6
    { const Params p = load_params(); const Bufs B = make_bufs(p.ws); att::attn_phase<PROBE_ABL>(p, B, l, ldsl, 1, PROBE_REP == 5 ? 1 : 0); }
    GRID_SYNC();
#endif
#if PROBE_REP == 4
    GRID_SYNC(); GRID_SYNC(); GRID_SYNC(); GRID_SYNC(); GRID_SYNC();
#endif
    { const Params p = load_params(); const Bufs B = make_bufs(p.ws); phase_outproj(ldsl, B, l); }
    GRID_SYNC();
}
__global__ void __launch_bounds__(NTHREADS) fwd_kernel(Params p_unused) {
    extern __shared__ __attribute__((aligned(16))) unsigned char lds_raw[];
#if !USE_CG_SYNC
    if (threadIdx.x == 0) { volatile XB_LAS unsigned* st = (volatile XB_LAS unsigned*)((XB_LAS unsigned char*)lds_raw + LDS_BAR_OFF); st[0] = 0u; st[1] = 0u; }
    __syncthreads();
    { const Params p = load_params(); xcd_barrier_post((unsigned*)(p.ws + OFF_CTL) + BAR_WORD0); }
#endif
    { const Params p = load_params(); const Bufs B = make_bufs(p.ws); phase_prologue(p, B, (float*)lds_raw); }
    GRID_SYNC();
#if PROBE_REP == 7
    { const Params p = load_params(); const Bufs B = make_bufs(p.ws); phase_prologue(p, B, (float*)lds_raw); }
    GRID_SYNC();
#endif
    run_layer<0>(lds_raw);
    run_layer<1>(lds_raw);
    { const Params p = load_params(); const Bufs B = make_bufs(p.ws); phase_final(p, B); }
#if PROBE_REP == 8
    GRID_SYNC();
    { const Params p = load_params(); const Bufs B = make_bufs(p.ws); phase_final(p, B); }
#endif
}

extern "C" void kernel_launch(void* const* d_in, const int* in_sizes, int n_in, void* d_out, int out_size, void* d_ws, size_t ws_size, hipStream_t stream) {
    static int grid_blocks = 0;
    if (grid_blocks == 0) {
        if (n_in != 14 || ws_size < WS_END + (PROBE_ABL ? (size_t)MPAD * 2048 + (size_t)32 * MROWS * 4 : 0)) { fprintf(stderr, "kernel_launch: unexpected n_in %d or ws_size %zu (need %zu)\n", n_in, ws_size, (size_t)WS_END); grid_blocks = -1; return; }
        int dev = 0, cus = 0, per_cu = 0;
        hipGetDevice(&dev);
        hipDeviceGetAttribute(&cus, hipDeviceAttributeMultiprocessorCount, dev);
        hipFuncSetAttribute((const void*)fwd_kernel, hipFuncAttributeMaxDynamicSharedMemorySize, LDS_BYTES);
        hipOccupancyMaxActiveBlocksPerMultiprocessor(&per_cu, (const void*)fwd_kernel, NTHREADS, LDS_BYTES);
        if (per_cu < 1) { fprintf(stderr, "kernel_launch: occupancy query says %d blocks per CU\n", per_cu); per_cu = 1; }
        if (per_cu > 1) per_cu = 1;
        grid_blocks = cus * per_cu;
        (void)hipGetLastError();
    }
    if (grid_blocks < 0) return;
    Params p{};
    p.x = (const float*)d_in[0]; p.meta = (const float*)d_in[1]; p.relb = (const float*)d_in[2]; p.norm_in = (const float*)d_in[3]; p.w_in = (const float*)d_in[4];
    p.sink = (const float*)d_in[5]; p.norm_q = (const float*)d_in[6]; p.w_uq = (const float*)d_in[7]; p.norm_kv = (const float*)d_in[8]; p.w_ukv = (const float*)d_in[9];
    p.norm_oa = (const float*)d_in[10]; p.norm_ob = (const float*)d_in[11]; p.w_out = (const float*)d_in[12]; p.norm_f = (const float*)d_in[13];
    p.out = (float*)d_out; p.ws = (unsigned char*)d_ws;
    if (hipMemsetAsync((char*)d_ws + OFF_CTL, 0, CTL_BYTES, stream) != hipSuccess) { fprintf(stderr, "kernel_launch: memset of control words failed\n"); return; }
    void* args[] = {&p};
    hipError_t e = hipLaunchCooperativeKernel((const void*)fwd_kernel, dim3(grid_blocks), dim3(NTHREADS), args, LDS_BYTES, stream);
    if (e != hipSuccess) fprintf(stderr, "cooperative launch failed: %s (grid %d)\n", hipGetErrorString(e), grid_blocks);
}
```

```cpp
#include <hip/hip_runtime.h>
#include <hip/hip_cooperative_groups.h>
#include <cstdio>
#include <cstdint>
namespace cg = cooperative_groups;

#ifndef PROBE_REP
#define PROBE_REP 0
#endif
#ifndef PROBE_ABL
#define PROBE_ABL 0
#endif
#ifndef USE_CG_SYNC
#define USE_CG_SYNC 0
#endif
constexpr int DM = 1024, NBATCH = 16, SEQ = 2048, NMETA = 16, LTOK = SEQ + NMETA, MROWS = NBATCH * LTOK;
constexpr int MPAD = MROWS + 256;
constexpr int INW = 2208, N1 = 2304;
constexpr int NTHREADS = 512;
constexpr float EPS = 1e-6f;
constexpr float LOG2E = 1.4426950408889634f;
constexpr float QA_SCALE = 0.125f * LOG2E;
constexpr float QB_SCALE = 0.10206207261596577f * LOG2E;
constexpr int BIASW = 4128;

typedef unsigned short bf16_t;
typedef float nt_f4 __attribute__((ext_vector_type(4)));
typedef unsigned int u32;

__device__ __forceinline__ float bf2f(bf16_t v) { return __uint_as_float(((u32)v) << 16); }
__device__ __forceinline__ bf16_t f2bf(float f) { u32 u = __float_as_uint(f); u = (u + 0x7fffu + ((u >> 16) & 1u)) >> 16; return (bf16_t)u; }

constexpr size_t al256(size_t x) { return (x + 255) & ~(size_t)255; }
constexpr size_t OFF_CTL = 0;
constexpr size_t CTL_BYTES = 32768;
constexpr size_t OFF_COS = CTL_BYTES;
constexpr size_t OFF_SIN = OFF_COS + al256((size_t)LTOK * 16 * 4);
constexpr size_t OFF_BIAS = OFF_SIN + al256((size_t)LTOK * 16 * 4);
constexpr size_t OFF_A2T = OFF_BIAS + al256((size_t)8 * BIASW * 4);
constexpr size_t OFF_SSQH = OFF_A2T + al256((size_t)2 * 2560 * 4);
constexpr size_t OFF_SSQY = OFF_SSQH + al256((size_t)16 * MROWS * 4);
constexpr size_t OFF_SSQC = OFF_SSQY + al256((size_t)32 * MROWS * 4);
constexpr size_t OFF_W1T = OFF_SSQC + al256((size_t)8 * MROWS * 4);
constexpr size_t OFF_W2QT = OFF_W1T + al256((size_t)2 * N1 * 1024 * 2);
constexpr size_t OFF_W3T = OFF_W2QT + al256((size_t)2 * 1792 * 256 * 2);
constexpr size_t OFF_H = OFF_W3T + al256((size_t)2 * 1024 * 1024 * 2);
constexpr size_t OFF_QA = OFF_H + al256((size_t)MPAD * 1024 * 2);
constexpr size_t OFF_KA = OFF_QA + al256((size_t)MPAD * 512 * 2);
constexpr size_t OFF_VA = OFF_KA + al256((size_t)MPAD * 128 * 2);
constexpr size_t OFF_GAS = OFF_VA + al256((size_t)MPAD * 128 * 2);
constexpr size_t OFF_GBS = OFF_GAS + al256((size_t)MPAD * 512 * 2);
constexpr size_t OFF_CQ = OFF_GBS + al256((size_t)MPAD * 512 * 2);
constexpr size_t OFF_QBN = OFF_CQ + al256((size_t)MPAD * 512 * 2);
constexpr size_t OFF_QBR = OFF_QBN + al256((size_t)MPAD * 512 * 2);
constexpr size_t OFF_KNB = OFF_QBR + al256((size_t)MPAD * 256 * 2);
constexpr size_t OFF_VB = OFF_KNB + al256((size_t)MPAD * 512 * 2);
constexpr size_t OFF_Y = OFF_VB + al256((size_t)MPAD * 512 * 2);
constexpr size_t WS_END = OFF_Y + al256((size_t)MPAD * 1024 * 2);

struct Params {
    const float* x; const float* meta; const float* relb; const float* norm_in; const float* w_in; const float* sink; const float* norm_q; const float* w_uq;
    const float* norm_kv; const float* w_ukv; const float* norm_oa; const float* norm_ob; const float* w_out; const float* norm_f;
    float* out; unsigned char* ws;
};

struct Bufs {
    unsigned char* ws;
#define BUF_F(name, off) __device__ __forceinline__ float* name() const { return (float*)(ws + (off)); }
#define BUF_H(name, off) __device__ __forceinline__ bf16_t* name() const { return (bf16_t*)(ws + (off)); }
    BUF_F(cosT, OFF_COS) BUF_F(sinT, OFF_SIN) BUF_F(bias, OFF_BIAS) BUF_F(ssqh, OFF_SSQH) BUF_F(ssqy, OFF_SSQY) BUF_F(ssqc, OFF_SSQC)
    BUF_H(w1t, OFF_W1T) BUF_H(w2, OFF_W2QT) BUF_H(w3t, OFF_W3T) BUF_H(H, OFF_H) BUF_H(QA, OFF_QA) BUF_H(KA, OFF_KA) BUF_H(VA, OFF_VA)
    BUF_H(GAS, OFF_GAS) BUF_H(GBS, OFF_GBS) BUF_H(CQX, OFF_CQ) BUF_H(QBN, OFF_QBN) BUF_H(QBR, OFF_QBR) BUF_H(KNB, OFF_KNB) BUF_H(VB, OFF_VB) BUF_H(Y, OFF_Y)
#undef BUF_F
#undef BUF_H
};
__device__ __forceinline__ Bufs make_bufs(unsigned char* ws) { Bufs b; b.ws = ws; return b; }

__device__ __forceinline__ float wave_sum(float v) {
#pragma unroll
    for (int o = 1; o < 64; o <<= 1) v += __shfl_xor(v, o);
    return v;
}
__device__ __forceinline__ int t5_bucket(int rel) {
    const int ret = rel > 0 ? 16 : 0; const int n = rel < 0 ? -rel : rel;
    int b;
    if (n < 8) b = n;
    else b = n >= 91 ? 15 : n >= 64 ? 14 : n >= 46 ? 13 : n >= 32 ? 12 : n >= 23 ? 11 : n >= 16 ? 10 : n >= 12 ? 9 : 8;
    return ret + b;
}

__device__ __forceinline__ void transpose_item(const float* W, int ldw, const float* gain, int k0, int kvalid, int srcbase, bool perm, bool zero, bf16_t* WT, int Kd, int n0, float* scr, int lane) {
#pragma unroll 4
    for (int i = 0; i < 32; ++i) {
        const int kk = 2 * i + (lane >> 5), c = lane & 31, k = k0 + kk;
        float v = 0.f;
        if (!zero && k < kvalid) { const int sc = srcbase + (perm ? ((c >> 1) + 16 * (c & 1)) : c); v = W[(size_t)k * ldw + sc]; if (gain) v *= gain[k]; }
        scr[kk * 33 + c] = v;
    }
    __builtin_amdgcn_s_waitcnt(0xc07f); asm volatile("" ::: "memory");
    const int c8 = lane & 7;
#pragma unroll
    for (int j = 0; j < 4; ++j) {
        const int n = (lane >> 3) + 8 * j; const float* s = scr + (8 * c8) * 33 + n;
        uint4 o;
        o.x = (u32)f2bf(s[0 * 33]) | ((u32)f2bf(s[1 * 33]) << 16); o.y = (u32)f2bf(s[2 * 33]) | ((u32)f2bf(s[3 * 33]) << 16);
        o.z = (u32)f2bf(s[4 * 33]) | ((u32)f2bf(s[5 * 33]) << 16); o.w = (u32)f2bf(s[6 * 33]) | ((u32)f2bf(s[7 * 33]) << 16);
        *(uint4*)(WT + (size_t)(n0 + n) * Kd + k0 + 8 * c8) = o;
    }
    __builtin_amdgcn_s_waitcnt(0xc07f); asm volatile("" ::: "memory");
}

__device__ __forceinline__ void phase_prologue(const Params& p, const Bufs& B, float* lds) {
    const int tid = threadIdx.x, lane = tid & 63, wave = tid >> 6;
    const int gw = blockIdx.x * 8 + wave, NGW = gridDim.x * 8;
    float* scr = lds + wave * (64 * 33);
    constexpr int I1 = 16 * 72;
    constexpr int I2 = 4 * 24;
    constexpr int I3 = 4 * 32;
    constexpr int I4 = 16 * 32;
    constexpr int IL = I1 + I2 + I3 + I4;
    for (int it = gw; it < 2 * IL; it += NGW) {
        const int l = it / IL; int r = it % IL;
        if (r < I1) {
            const int kb = r / 72, nb = r % 72, n0 = nb * 32;
            int srcbase = 0; bool perm = false, zero = false;
            if (n0 < 1280) srcbase = n0;
            else if (n0 < 1792) srcbase = 1696 + (n0 - 1280);
            else if (n0 < 2048) srcbase = 1280 + (n0 - 1792);
            else { const int j = n0 - 2048; if (j < 128) srcbase = 1536 + j; else if (j < 160) { srcbase = 1664; perm = true; } else zero = true; }
            transpose_item(p.w_in + (size_t)l * 1024 * INW, INW, p.norm_in + l * 1024, kb * 64, 1024, srcbase, perm, zero, B.w1t() + (size_t)l * N1 * 1024, 1024, n0, scr, lane);
            continue;
        }
        r -= I1;
        if (r < I2) {
            const int kb = r / 24, nb = r % 24, n0 = nb * 32;
            int srcbase; bool perm = false;
            if (n0 < 512) { const int h = n0 / 64, d0 = n0 % 64; srcbase = 96 * h + d0; }
            else { const int h = (n0 - 512) / 32; srcbase = 96 * h + 64; perm = true; }
            transpose_item(p.w_uq + (size_t)l * 256 * 768, 768, p.norm_q + l * 256, kb * 64, 256, srcbase, perm, false, B.w2() + (size_t)l * 1792 * 256, 256, n0, scr, lane);
            continue;
        }
        r -= I2;
        if (r < I3) {
            const int kb = r / 32, nb = r % 32, n0 = nb * 32;
            int srcbase;
            if (n0 < 512) { const int h = n0 / 64, d0 = n0 % 64; srcbase = 128 * h + d0; }
            else { const int j = n0 - 512, h = j / 64, d0 = j % 64; srcbase = 128 * h + 64 + d0; }
            transpose_item(p.w_ukv + (size_t)l * 128 * 1024, 1024, p.norm_kv + l * 128, kb * 64, 128, srcbase, false, false, B.w2() + (size_t)l * 1792 * 256 + (size_t)768 * 256, 256, n0, scr, lane);
            continue;
        }
        r -= I3;
        {
            const int kb = r / 32, nb = r % 32, n0 = nb * 32;
            transpose_item(p.w_out + (size_t)l * 1024 * 1024, 1024, nullptr, kb * 64, 1024, n0, false, false, B.w3t() + (size_t)l * 1024 * 1024, 1024, n0, scr, lane);
        }
    }
    for (int r0 = gw * 4; r0 < MROWS; r0 += NGW * 4) {
        float4 v[4][4];
#pragma unroll
        for (int q = 0; q < 4; ++q) {
            const int r = r0 + q, b = r / LTOK, pp = r % LTOK;
            const float* src = pp < NMETA ? p.meta + (size_t)pp * DM : p.x + ((size_t)b * SEQ + (pp - NMETA)) * DM;
#pragma unroll
            for (int j = 0; j < 4; ++j) { const nt_f4 t_ = __builtin_nontemporal_load((const nt_f4*)(src + j * 256 + lane * 4)); v[q][j] = make_float4(t_.x, t_.y, t_.z, t_.w); }
        }
#pragma unroll
        for (int q = 0; q < 4; ++q) {
            const int r = r0 + q; float s = 0.f;
#pragma unroll
            for (int j = 0; j < 4; ++j) {
                const float4 w = v[q][j];
                s += w.x * w.x + w.y * w.y + w.z * w.z + w.w * w.w;
                uint2 o; o.x = (u32)f2bf(w.x) | ((u32)f2bf(w.y) << 16); o.y = (u32)f2bf(w.z) | ((u32)f2bf(w.w) << 16);
                *(uint2*)(B.H() + (size_t)r * DM + j * 256 + lane * 4) = o;
            }
            s = wave_sum(s);
            if (lane < 16) B.ssqh()[(size_t)lane * MROWS + r] = lane == 0 ? s : 0.f;
        }
    }
    const int gt = blockIdx.x * NTHREADS + tid, NGT = gridDim.x * NTHREADS;
    if (gt < 1024) ((unsigned*)(p.ws + OFF_CTL))[gt] = 0u;
    for (int i = gt; i < 64 * 512 / 8; i += NGT) ((uint4*)(B.VB() + (size_t)MROWS * 512))[i] = make_uint4(0u, 0u, 0u, 0u);
    for (int i = gt; i < LTOK * 16; i += NGT) {
        const int pos = i >> 4, j = i & 15;
        const float freq = exp2f(-(float)j * (13.287712379549449f / 16.0f));
        const float ang = (float)pos * freq;
        B.cosT()[i] = cosf(ang); B.sinT()[i] = sinf(ang);
    }
    for (int i = gt; i < 8 * BIASW; i += NGT) {
        const int h = i / BIASW, rel = (i % BIASW) - LTOK;
        B.bias()[i] = p.relb[t5_bucket(rel) * 8 + h] * LOG2E;
    }
    for (int i = gt; i < 2 * 2560; i += NGT) {
        const int g = i / 2560, t = (i % 2560) / 1280, j = i % 1280, hq = j / 320, rel = (j % 320) - 160;
        const float bv = p.relb[t5_bucket(rel) * 8 + 4 * g + hq] * LOG2E;
        ((float*)(B.ws + OFF_A2T))[i] = (t == 0 && (rel < -128 || rel > 128)) ? -INFINITY : bv;
    }
}

__device__ __forceinline__ float row_rs16(const float* part, int r, float inv_n) {
    float s = 0.f;
#pragma unroll
    for (int i = 0; i < 16; ++i) s += part[(size_t)i * MROWS + r];
    return rsqrtf(s * inv_n + EPS);
}


namespace pg8 {
#define PG8_LAS __attribute__((address_space(3)))
typedef short bf16x8 __attribute__((ext_vector_type(8)));
typedef float f32x4 __attribute__((ext_vector_type(4)));
typedef unsigned u32x4 __attribute__((ext_vector_type(4)));
constexpr int BM = 256, BK = 64, HALF = 128, HTB = HALF * BK * 2, STAGE_BYTES = 8 * HTB, NXCD = 8, WGM = 8;
constexpr int XTRA_OFF = STAGE_BYTES;
constexpr int MAXU = 6;

__device__ __forceinline__ int lds_byte(int r, int c) { const int st = (r >> 4) * 2 + (c >> 5), rr = r & 15, cc = c & 31, ob = rr * 64 + cc * 2; return st * 1024 + (ob ^ (((ob >> 9) & 1) << 5)); }
__device__ __forceinline__ void stage_rc(int b, int& R, int& C) { const int st = b / 1024, sb = b % 1024, swz = sb ^ (((sb >> 9) & 1) << 5); R = (st >> 1) * 16 + swz / 64; C = (st & 1) * 32 + (swz % 64) / 2; }
__device__ __forceinline__ int perm32(int rho) { const int n = rho >> 4, i = rho & 15; return 8 * (i >> 2) + 4 * n + (i & 3); }

struct Unit { int pm, pn; };
struct Gemm { const bf16_t* A; const bf16_t* Bt; int M, N, K; int lda = 0  ; int asplit = 1 << 30, aoffc = 0  , k2 = 0  ; };
struct StaticOrder {
    int nM, nN, nwg, G, c;
    __device__ void init(int M, int N, int G_, int c_) { nM = M / BM; nN = N / BM; nwg = nM * nN; G = G_; c = c_; }
    __device__ bool next(int i, Unit& u) const {
        const long L = (long)i * G + c; if (L >= nwg) return false;
        int wgid = (int)L; { const int q = nwg / NXCD, r = nwg % NXCD, xcd = wgid % NXCD, off = wgid / NXCD; wgid = (xcd < r ? xcd * (q + 1) : r * (q + 1) + (xcd - r) * q) + off; }
        const int nig = WGM * nN, gid = wgid / nig, fm = gid * WGM, gsz = (nM - fm) < WGM ? (nM - fm) : WGM;
        u.pm = fm + ((wgid % nig) % gsz); u.pn = (wgid % nig) / gsz; return true;
    }
};
__device__ __forceinline__ unsigned cvt_pk_bf16(float lo, float hi) { unsigned r; asm volatile("v_cvt_pk_bf16_f32 %0, %1, %2" : "=v"(r) : "v"(lo), "v"(hi)); return r; }

template <class Epi>
__device__ __forceinline__ void gemm_phase(PG8_LAS unsigned char* lds, const Gemm g, const StaticOrder& S, const Epi& E) {
    int tid_ = threadIdx.x; asm volatile("" : "+v"(tid_));
    const int tid = tid_, wid = __builtin_amdgcn_readfirstlane(tid >> 6), lane = tid & 63, wr = wid >> 2, wc = wid & 3, fr = lane & 15, fq = lane >> 4;
    const int K = g.K, nt = K / BK, lda = g.lda ? g.lda : g.K;
    unsigned voffA[2], voffB[2];
#pragma unroll
    for (int i = 0; i < 2; ++i) { int R, C; stage_rc(tid * 16 + i * 8192, R, C); const int Rb = Epi::PERM ? ((R & ~31) + perm32(R & 31)) : R;
        voffA[i] = (unsigned)(R * lda + C) * 2u; voffB[i] = (unsigned)(Rb * K + C) * 2u; }
    const size_t kstep = (size_t)(BK * 2);
    const size_t hstep = (size_t)HALF * K * 2, hstepA = (size_t)HALF * lda * 2;
    const size_t tstep = 2 * hstep, tstepA = 2 * hstepA;
#define PG8_ABASE(u) ((const char*)g.A + (size_t)(u).pm * tstepA + ((u).pn >= g.asplit ? (size_t)g.aoffc * 2 : (size_t)0))
    const unsigned ldsw = (unsigned)wid * 1024u;
    const int aoff = lds_byte(wr * 64 + fr, fq * 8), boff = lds_byte(wc * 32 + fr, fq * 8);
#define PG8_SA(b, h) (((b) * 2 + (h)) * HTB)
#define PG8_SB(b, h) ((4 + (b) * 2 + (h)) * HTB)
#define PG8_STAGE(bufoff, gbase, voff) do { _Pragma("unroll") for (int _i = 0; _i < 2; ++_i) \
        __builtin_amdgcn_global_load_lds((const unsigned*)((const char*)(gbase) + (voff)[_i]), (PG8_LAS unsigned*)(lds + (bufoff) + ldsw + _i * 8192), 16, 0, 0); } while (0)
#define PG8_LDA(dst, b, h) do { _Pragma("unroll") for (int m = 0; m < 4; ++m) _Pragma("unroll") for (int k = 0; k < 2; ++k) dst[m][k] = *(const PG8_LAS bf16x8*)(lds + PG8_SA(b, h) + aoff + m * 2048 + k * 1024); } while (0)
#define PG8_LDB(dst, b, h) do { _Pragma("unroll") for (int n = 0; n < 2; ++n) _Pragma("unroll") for (int k = 0; k < 2; ++k) dst[n][k] = *(const PG8_LAS bf16x8*)(lds + PG8_SB(b, h) + boff + n * 2048 + k * 1024); } while (0)
#define PG8_MMA(ai, bj, At, Bt) do { __builtin_amdgcn_s_setprio(1); _Pragma("unroll") for (int m = 0; m < 4; ++m) _Pragma("unroll") for (int n = 0; n < 2; ++n) _Pragma("unroll") for (int k = 0; k < 2; ++k) \
        acc[ai][bj][m][n] = __builtin_amdgcn_mfma_f32_16x16x32_bf16(Bt[n][k], At[m][k], acc[ai][bj][m][n], 0, 0, 0); __builtin_amdgcn_s_setprio(0); } while (0)
#define PG8_WAIT_V(n) asm volatile("s_waitcnt vmcnt(" #n ")" ::: "memory")
#define PG8_WAIT_L(n) asm volatile("s_waitcnt lgkmcnt(" #n ")" ::: "memory")
#define PG8_BAR __builtin_amdgcn_s_barrier()
#define PG8_SCHED __builtin_amdgcn_sched_barrier(0)
    Unit cur, nxt; int ui = 0;
    if (!S.next(0, cur)) return;
    f32x4 acc[2][2][4][2];
#pragma unroll
    for (int a = 0; a < 2; ++a)
#pragma unroll
        for (int b = 0; b < 2; ++b)
#pragma unroll
            for (int m = 0; m < 4; ++m)
#pragma unroll
                for (int n = 0; n < 2; ++n) acc[a][b][m][n] = (f32x4){0.f, 0.f, 0.f, 0.f};
    bf16x8 At[4][2], B0[2][2], B1[2][2];
    const char* cA = PG8_ABASE(cur); const char* cB = (const char*)g.Bt + (size_t)cur.pn * tstep;
    PG8_STAGE(PG8_SB(0, 0), cB, voffB); PG8_STAGE(PG8_SB(0, 1), cB + hstep, voffB); PG8_STAGE(PG8_SA(0, 0), cA, voffA); PG8_STAGE(PG8_SA(0, 1), cA + hstepA, voffA);
    if (wr == 1) PG8_BAR;
    PG8_WAIT_V(2); PG8_BAR;
    PG8_STAGE(PG8_SB(1, 0), cB + kstep, voffB); PG8_STAGE(PG8_SA(1, 0), cA + kstep, voffA); PG8_STAGE(PG8_SB(1, 1), cB + hstep + kstep, voffB);
    PG8_WAIT_V(6); PG8_BAR;
    for (;;) {
        const bool has_next = S.next(ui + 1, nxt);
        const char* nA = has_next ? PG8_ABASE(nxt) : cA; const char* nB = has_next ? (const char*)g.Bt + (size_t)nxt.pn * tstep : cB;
        PG8_LAS const float* xs = (PG8_LAS const float*)(lds + XTRA_OFF) + ui * 512;
        const int ntu = (g.k2 && cur.pn >= g.asplit) ? g.k2 / BK : nt;
#pragma unroll 1
        for (int t = 0; t < ntu; t += 2) {
            const bool last = (t == ntu - 2);
            const char* a1 = cA + (size_t)(t + 1) * kstep;
            const char* a2 = last ? nA : cA + (size_t)(t + 2) * kstep; const char* b2 = last ? nB : cB + (size_t)(t + 2) * kstep;
            const char* a3 = a2 + kstep; const char* b3 = b2 + kstep;
            if constexpr (Epi::HAS_MID) { if (t == (ntu >> 1)) E.mid(acc, wr, fr, xs); }
            PG8_LDB(B0, 0, 0); PG8_LDB(B1, 0, 1); PG8_SCHED; PG8_LDA(At, 0, 0); PG8_STAGE(PG8_SA(1, 1), a1 + hstepA, voffA);
            PG8_WAIT_V(8); PG8_WAIT_L(0); PG8_BAR; PG8_MMA(0, 0, At, B0); PG8_MMA(0, 1, At, B1); PG8_BAR; PG8_SCHED;
            PG8_LDA(At, 0, 1); PG8_STAGE(PG8_SB(0, 0), b2, voffB); PG8_STAGE(PG8_SB(0, 1), b2 + hstep, voffB); PG8_STAGE(PG8_SA(0, 0), a2, voffA);
            PG8_WAIT_V(8); PG8_WAIT_L(0); PG8_BAR; PG8_MMA(1, 0, At, B0); PG8_MMA(1, 1, At, B1); PG8_BAR; PG8_SCHED;
            PG8_LDB(B0, 1, 0); PG8_LDB(B1, 1, 1); PG8_SCHED; PG8_LDA(At, 1, 0); PG8_STAGE(PG8_SA(0, 1), a2 + hstepA, voffA);
            PG8_WAIT_V(8); PG8_WAIT_L(0); PG8_BAR; PG8_MMA(0, 0, At, B0); PG8_MMA(0, 1, At, B1); PG8_BAR; PG8_SCHED;
            PG8_LDA(At, 1, 1); PG8_STAGE(PG8_SB(1, 0), b3, voffB); PG8_STAGE(PG8_SB(1, 1), b3 + hstep, voffB); PG8_STAGE(PG8_SA(1, 0), a3, voffA);
            PG8_WAIT_V(8); PG8_WAIT_L(0); PG8_BAR; PG8_MMA(1, 0, At, B0); PG8_MMA(1, 1, At, B1); PG8_BAR; PG8_SCHED;
        }
        if (wr == 0) PG8_BAR;
        E(acc, cur, wr, wc, fr, fq, xs);
        if (!has_next) break;
#pragma unroll
        for (int a = 0; a < 2; ++a)
#pragma unroll
            for (int b = 0; b < 2; ++b)
#pragma unroll
                for (int m = 0; m < 4; ++m)
#pragma unroll
                    for (int n = 0; n < 2; ++n) acc[a][b][m][n] = (f32x4){0.f, 0.f, 0.f, 0.f};
        cur = nxt; cA = nA; cB = nB; ++ui;
        if (wr == 1) PG8_BAR;
    }
    PG8_WAIT_V(0);
    PG8_BAR;
#undef PG8_ABASE
#undef PG8_SA
#undef PG8_SB
#undef PG8_STAGE
#undef PG8_LDA
#undef PG8_LDB
#undef PG8_MMA
#undef PG8_WAIT_V
#undef PG8_WAIT_L
#undef PG8_BAR
#undef PG8_SCHED
}

template <class F>
__device__ __forceinline__ void fill_row_scalars(PG8_LAS unsigned char* lds, const StaticOrder& S, const F& f) {
    PG8_LAS float* xs = (PG8_LAS float*)(lds + XTRA_OFF);
    Unit u; const int row = threadIdx.x & 255, j = threadIdx.x >> 8;
    for (int i = 0; i < MAXU && S.next(i, u); ++i) xs[i * 512 + j * 256 + row] = f(j, u.pm * BM + row);
    __syncthreads();
}
}

__device__ __forceinline__ float fast_silu(float v) { return v * __builtin_amdgcn_rcpf(1.0f + __builtin_amdgcn_exp2f(-v * LOG2E)); }

__device__ __forceinline__ size_t qfrag_idx(size_t r, int h, int d, int nks, int sh = 0) {
    const int b = (int)(r / LTOK), P = (int)(r - (size_t)b * LTOK) + sh;
    return (((((size_t)(b * 65 + (P >> 5)) * 8 + h) * nks + (d >> 4)) * 2 + ((d >> 3) & 1)) * 32 + (P & 31)) * 8;
}
constexpr int QB_SHIFT = 16;
__device__ __forceinline__ size_t qfrag_blk(int b, int blk, int h, int ks, int hi, int nks) { return ((((size_t)(b * 65 + blk) * 8 + h) * nks + ks) * 2 + hi) * 256; }

struct EpiInProj {
    static constexpr bool PERM = true, HAS_MID = false;
    Bufs B; const float* goa; const float* gob;
    template <int KIND>
    __device__ __forceinline__ void tile(const pg8::f32x4 (&acc)[2][2][4][2], const pg8::Unit& u, int wr, int wc, int fr, int fq, PG8_LAS const float* xs) const {
        using pg8::f32x4; using pg8::u32x4; using pg8::cvt_pk_bf16;
        const int pn = u.pn, cl = wc * 32 + 8 * fq;
        const int rl0 = wr * 64 + fr; const size_t r0 = (size_t)u.pm * 256 + rl0;
        bf16_t* d0; bf16_t* d1; int ld;
        const float* gg = nullptr;
        if (KIND == 0) { ld = 512; d0 = B.QA() + r0 * 512 + pn * 256 + cl; d1 = d0 + 128; }
        else if (KIND == 1) { ld = 128; d0 = B.KA() + r0 * 128 + cl; d1 = B.VA() + r0 * 128 + cl; }
        else if (KIND == 2) { ld = 512; const int c = ((pn - 3) & 1) * 256 + cl; gg = (pn < 5 ? goa : gob) + c; d0 = (pn < 5 ? B.GAS() : B.GBS()) + r0 * 512 + c; d1 = d0 + 128; }
        else if (KIND == 3) { ld = 512; d0 = B.CQX() + r0 * 512 + cl; d1 = d0 + 128; }
        else { ld = 512; d0 = B.CQX() + r0 * 512 + 256 + cl; d1 = d0 + 128; }
        f32x4 g[2][2];
        if (KIND == 2) { g[0][0] = *(const f32x4*)gg; g[0][1] = *(const f32x4*)(gg + 4); g[1][0] = *(const f32x4*)(gg + 128); g[1][1] = *(const f32x4*)(gg + 132); }
#pragma unroll
        for (int ai = 0; ai < 2; ++ai)
#pragma unroll
            for (int m = 0; m < 4; ++m) {
                const int ro = ai * 128 + m * 16; const float rs = xs[rl0 + ro];
                float ssq = 0.f;
#pragma unroll
                for (int bj = 0; bj < 2; ++bj) {
                    f32x4 v0 = acc[ai][bj][m][0] * rs, v1 = acc[ai][bj][m][1] * rs;
                    if (KIND == 0) { v0 = v0 * QA_SCALE; v1 = v1 * QA_SCALE; }
                    if (KIND == 2) {
                        const float rsn = rs * -LOG2E;
                        const f32x4 t0 = acc[ai][bj][m][0] * rsn, t1 = acc[ai][bj][m][1] * rsn;
                        f32x4 e0, e1;
#pragma unroll
                        for (int j = 0; j < 4; ++j) { e0[j] = __builtin_amdgcn_exp2f(t0[j]); e1[j] = __builtin_amdgcn_exp2f(t1[j]); }
                        e0 = e0 + 1.0f; e1 = e1 + 1.0f;
                        f32x4 s0, s1;
#pragma unroll
                        for (int j = 0; j < 4; ++j) { s0[j] = __builtin_amdgcn_rcpf(e0[j]); s1[j] = __builtin_amdgcn_rcpf(e1[j]); }
                        v0 = (v0 * g[bj][0]) * s0; v1 = (v1 * g[bj][1]) * s1;
                    }
                    if (KIND == 3 || (KIND == 4 && bj == 0))
                        ssq += (v0[0] * v0[0] + v0[1] * v0[1]) + (v0[2] * v0[2] + v0[3] * v0[3]) + (v1[0] * v1[0] + v1[1] * v1[1]) + (v1[2] * v1[2] + v1[3] * v1[3]);
                    if (KIND == 4 && bj == 1) {
                        if (wc == 0) {
                            const int pos = (int)((r0 + ro) % LTOK);
                            const f32x4 cs = *(const f32x4*)(B.cosT() + pos * 16 + 4 * fq), sn = *(const f32x4*)(B.sinT() + pos * 16 + 4 * fq);
                            const f32x4 a0 = v0, a1 = v1;
                            v0[0] = a0[0] * cs[0] - a0[1] * sn[0]; v0[1] = a0[1] * cs[0] + a0[0] * sn[0]; v0[2] = a0[2] * cs[1] - a0[3] * sn[1]; v0[3] = a0[3] * cs[1] + a0[2] * sn[1];
                            v1[0] = a1[0] * cs[2] - a1[1] * sn[2]; v1[1] = a1[1] * cs[2] + a1[0] * sn[2]; v1[2] = a1[2] * cs[3] - a1[3] * sn[3]; v1[3] = a1[3] * cs[3] + a1[2] * sn[3];
                        }
                    }
                    u32x4 w; w.x = cvt_pk_bf16(v0[0], v0[1]); w.y = cvt_pk_bf16(v0[2], v0[3]); w.z = cvt_pk_bf16(v1[0], v1[1]); w.w = cvt_pk_bf16(v1[2], v1[3]);
                    if (KIND == 0) { const int c = pn * 256 + bj * 128 + cl; *(u32x4*)(B.QA() + qfrag_idx(r0 + ro, c >> 6, c & 63, 4)) = w; }
                    else *(u32x4*)((bj == 0 ? d0 : d1) + (size_t)ro * ld) = w;
                }
                if (KIND >= 3) {
                    ssq += __shfl_xor(ssq, 16); ssq += __shfl_xor(ssq, 32);
                    if (fq == 0) B.ssqc()[(size_t)((KIND - 3) * 4 + wc) * MROWS + r0 + ro] = ssq;
                }
                asm volatile("" ::: "memory");
            }
    }
    __device__ __forceinline__ void operator()(const pg8::f32x4 (&acc)[2][2][4][2], const pg8::Unit& u, int wr, int wc, int fr, int fq, PG8_LAS const float* xs) const {
        const int pn = u.pn;
        if (pn < 2) tile<0>(acc, u, wr, wc, fr, fq, xs);
        else if (pn == 2) tile<1>(acc, u, wr, wc, fr, fq, xs);
        else if (pn < 7) tile<2>(acc, u, wr, wc, fr, fq, xs);
        else if (pn == 7) tile<3>(acc, u, wr, wc, fr, fq, xs);
        else tile<4>(acc, u, wr, wc, fr, fq, xs);
    }
};
struct RowScalarH { const float* ssqh; __device__ __forceinline__ float operator()(int j, int r) const { return j == 0 ? row_rs16(ssqh, r, 1.0f / 1024.0f) : 0.f; } };

__device__ __forceinline__ void phase_inproj(PG8_LAS unsigned char* lds, const Params& p, const Bufs& B, int l) {
    pg8::Gemm g{B.H(), B.w1t() + (size_t)l * N1 * 1024, MROWS, N1, 1024}; pg8::StaticOrder S; S.init(MROWS, N1, gridDim.x, blockIdx.x);
    pg8::fill_row_scalars(lds, S, RowScalarH{B.ssqh()});
    EpiInProj E{B, p.norm_oa + l * 512, p.norm_ob + l * 512};
    pg8::gemm_phase(lds, g, S, E);
}

__device__ __forceinline__ float rs_c(const float* ssqc, int base, int r, float inv_n) {
    const float s = ssqc[(size_t)(base + 0) * MROWS + r] + ssqc[(size_t)(base + 1) * MROWS + r] + ssqc[(size_t)(base + 2) * MROWS + r] + ssqc[(size_t)(base + 3) * MROWS + r];
    return rsqrtf(s * inv_n + EPS);
}

struct EpiUp {
    static constexpr bool PERM = true, HAS_MID = false;
    Bufs B;
    template <int WHICH>
    __device__ __forceinline__ void tile(const pg8::f32x4 (&acc)[2][2][4][2], const pg8::Unit& u, int pn, int wr, int wc, int fr, int fq, PG8_LAS const float* xs) const {
        using pg8::f32x4; using pg8::u32x4; using pg8::cvt_pk_bf16;
        const int cl = wc * 32 + 8 * fq;
        const int rl0 = wr * 64 + fr; const size_t r0 = (size_t)u.pm * 256 + rl0;
        const bool rope = (WHICH == 0 && pn == 2);
        bf16_t* d0; int ld;
        if (WHICH == 0) { if (pn < 2) { ld = 512; d0 = B.QBN() + r0 * 512 + pn * 256 + cl; } else { ld = 256; d0 = B.QBR() + r0 * 256 + cl; } }
        else { ld = 512; d0 = (pn < 2 ? B.KNB() : B.VB()) + r0 * 512 + (pn & 1) * 256 + cl; }
        const float sc = (WHICH == 0) ? QB_SCALE : 1.0f;
#pragma unroll
        for (int ai = 0; ai < 2; ++ai)
#pragma unroll
            for (int m = 0; m < 4; ++m) {
                const int ro = ai * 128 + m * 16; const float rs = xs[WHICH * 256 + rl0 + ro] * sc;
                f32x4 cs, sn;
                if (rope) { const int pos = (int)((r0 + ro) % LTOK); cs = *(const f32x4*)(B.cosT() + pos * 16 + 4 * fq); sn = *(const f32x4*)(B.sinT() + pos * 16 + 4 * fq); }
#pragma unroll
                for (int bj = 0; bj < 2; ++bj) {
                    f32x4 v0 = acc[ai][bj][m][0] * rs, v1 = acc[ai][bj][m][1] * rs;
                    if (rope) {
                        const f32x4 a0 = v0, a1 = v1;
                        v0[0] = a0[0] * cs[0] - a0[1] * sn[0]; v0[1] = a0[1] * cs[0] + a0[0] * sn[0]; v0[2] = a0[2] * cs[1] - a0[3] * sn[1]; v0[3] = a0[3] * cs[1] + a0[2] * sn[1];
                        v1[0] = a1[0] * cs[2] - a1[1] * sn[2]; v1[1] = a1[1] * cs[2] + a1[0] * sn[2]; v1[2] = a1[2] * cs[3] - a1[3] * sn[3]; v1[3] = a1[3] * cs[3] + a1[2] * sn[3];
                    }
                    u32x4 w; w.x = cvt_pk_bf16(v0[0], v0[1]); w.y = cvt_pk_bf16(v0[2], v0[3]); w.z = cvt_pk_bf16(v1[0], v1[1]); w.w = cvt_pk_bf16(v1[2], v1[3]);
                    if (WHICH == 0) { const int c = (pn < 2 ? pn * 256 : 0) + bj * 128 + cl;
                        if (pn < 2) *(u32x4*)(B.QBN() + qfrag_idx(r0 + ro, c >> 6, c & 63, 4, QB_SHIFT)) = w; else *(u32x4*)(B.QBR() + qfrag_idx(r0 + ro, c >> 5, c & 31, 2, QB_SHIFT)) = w; }
                    else *(u32x4*)(d0 + bj * 128 + (size_t)ro * ld) = w;
                }
                asm volatile("" ::: "memory");
            }
    }
    __device__ __forceinline__ void operator()(const pg8::f32x4 (&acc)[2][2][4][2], const pg8::Unit& u, int wr, int wc, int fr, int fq, PG8_LAS const float* xs) const {
        if (u.pn < 3) tile<0>(acc, u, u.pn, wr, wc, fr, fq, xs); else tile<1>(acc, u, u.pn - 3, wr, wc, fr, fq, xs);
    }
};
struct RowScalarC { const float* ssqc; __device__ __forceinline__ float operator()(int j, int r) const { return j == 0 ? rs_c(ssqc, 0, r, 1.0f / 256.0f) : rs_c(ssqc, 4, r, 1.0f / 128.0f); } };
__device__ __forceinline__ void phase_upproj(PG8_LAS unsigned char* lds, const Bufs& B, int l) {
    pg8::Gemm g{B.CQX(), B.w2() + (size_t)l * 1792 * 256, MROWS, 1792, 256, 512, 3, 256, 128}; pg8::StaticOrder S; S.init(MROWS, 1792, gridDim.x, blockIdx.x);
    pg8::fill_row_scalars(lds, S, RowScalarC{B.ssqc()});
    EpiUp E{B}; pg8::gemm_phase(lds, g, S, E);
}

struct EpiOut {
    static constexpr bool PERM = true, HAS_MID = true;
    bf16_t* H; float* ssqh;
    __device__ __forceinline__ void mid(pg8::f32x4 (&acc)[2][2][4][2], int wr, int fr, PG8_LAS const float* xs) const {
#pragma unroll
        for (int ai = 0; ai < 2; ++ai)
#pragma unroll
            for (int m = 0; m < 4; ++m) { const float f = xs[ai * 128 + wr * 64 + m * 16 + fr];
#pragma unroll
                for (int bj = 0; bj < 2; ++bj)
#pragma unroll
                    for (int n = 0; n < 2; ++n) acc[ai][bj][m][n] = acc[ai][bj][m][n] * f; }
    }
    __device__ __forceinline__ void operator()(const pg8::f32x4 (&acc)[2][2][4][2], const pg8::Unit& u, int wr, int wc, int fr, int fq, PG8_LAS const float* xs) const {
        using pg8::f32x4; using pg8::u32x4; using pg8::cvt_pk_bf16;
        const int pn = u.pn, cl = wc * 32 + 8 * fq;
        const int rl0 = wr * 64 + fr; const size_t r0 = (size_t)u.pm * 256 + rl0;
        bf16_t* d0 = H + r0 * DM + pn * 256 + cl;
#pragma unroll
        for (int ai = 0; ai < 2; ++ai) {
            u32x4 hv[4][2];
#pragma unroll
            for (int m = 0; m < 4; ++m)
#pragma unroll
                for (int bj = 0; bj < 2; ++bj) hv[m][bj] = *(const u32x4*)(d0 + bj * 128 + (size_t)(ai * 128 + m * 16) * DM);
#pragma unroll
            for (int m = 0; m < 4; ++m) {
                const int ro = ai * 128 + m * 16; const float rb = xs[256 + rl0 + ro];
                float ssq = 0.f;
#pragma unroll
                for (int bj = 0; bj < 2; ++bj) {
                    bf16_t* dp = d0 + bj * 128 + (size_t)ro * DM;
                    const u32x4 h4 = hv[m][bj];
                    f32x4 v0 = acc[ai][bj][m][0] * rb, v1 = acc[ai][bj][m][1] * rb;
                    v0[0] += __uint_as_float(h4.x << 16); v0[1] += __uint_as_float(h4.x & 0xffff0000u); v0[2] += __uint_as_float(h4.y << 16); v0[3] += __uint_as_float(h4.y & 0xffff0000u);
                    v1[0] += __uint_as_float(h4.z << 16); v1[1] += __uint_as_float(h4.z & 0xffff0000u); v1[2] += __uint_as_float(h4.w << 16); v1[3] += __uint_as_float(h4.w & 0xffff0000u);
                    ssq += (v0[0] * v0[0] + v0[1] * v0[1]) + (v0[2] * v0[2] + v0[3] * v0[3]) + (v1[0] * v1[0] + v1[1] * v1[1]) + (v1[2] * v1[2] + v1[3] * v1[3]);
                    u32x4 w; w.x = cvt_pk_bf16(v0[0], v0[1]); w.y = cvt_pk_bf16(v0[2], v0[3]); w.z = cvt_pk_bf16(v1[0], v1[1]); w.w = cvt_pk_bf16(v1[2], v1[3]);
                    *(u32x4*)dp = w;
                }
                ssq += __shfl_xor(ssq, 16); ssq += __shfl_xor(ssq, 32);
                if (fq == 0) ssqh[(size_t)(pn * 4 + wc) * MROWS + r0 + ro] = ssq;
            }
            asm volatile("" ::: "memory");
        }
    }
};
struct RowScalarY {
    const float* ssqy;
    __device__ __forceinline__ float operator()(int j, int r) const {
        float sa = 0.f, sb = 0.f;
#pragma unroll
        for (int i = 0; i < 8; ++i) { sa += ssqy[(size_t)i * MROWS + r]; sb += ssqy[(size_t)(8 + i) * MROWS + r]; }
        const float ra = rsqrtf(sa * (1.0f / 512.0f) + EPS), rb = rsqrtf(sb * (1.0f / 512.0f) + EPS);
        return j == 0 ? ra / rb : rb;
    }
};
__device__ __forceinline__ void outproj_tail(PG8_LAS unsigned char* lds, const Bufs& B, int l) {
    typedef short bf16x8 __attribute__((ext_vector_type(8))); typedef float f32x4 __attribute__((ext_vector_type(4)));
    for (int c = blockIdx.x; c < 256; c += gridDim.x) {
        int tid_ = threadIdx.x; asm volatile("" : "+v"(tid_));
        const int tid = tid_, lane = tid & 63, wid = __builtin_amdgcn_readfirstlane(tid >> 6);
        const int rg = c >> 4, cg = c & 15, r0 = (MROWS - 256) + 16 * rg, n0 = 64 * cg;
        PG8_LAS float* part = (PG8_LAS float*)lds;
        PG8_LAS float* rsc = part + 8 * 1024;
        if (tid < 32) {
            const int row = tid & 15, j = tid >> 4; float sa = 0.f;
#pragma unroll
            for (int i = 0; i < 8; ++i) sa += B.ssqy()[(size_t)(8 * j + i) * MROWS + r0 + row];
            rsc[j * 16 + row] = rsqrtf(sa * (1.0f / 512.0f) + EPS);
        }
        const int fr = lane & 15, kq = lane >> 4;
        f32x4 acc[4];
#pragma unroll
        for (int cb = 0; cb < 4; ++cb) acc[cb] = (f32x4){0.f, 0.f, 0.f, 0.f};
        const bf16_t* Ap = B.Y() + (size_t)(r0 + fr) * 1024 + wid * 128 + kq * 8;
        const bf16_t* Bp = B.w3t() + (size_t)l * 1024 * 1024 + (size_t)(n0 + fr) * 1024 + wid * 128 + kq * 8;
#pragma unroll
        for (int ks = 0; ks < 4; ++ks) {
            const bf16x8 a = *(const bf16x8*)(Ap + ks * 32);
#pragma unroll
            for (int cb = 0; cb < 4; ++cb) { const bf16x8 bb = *(const bf16x8*)(Bp + (size_t)cb * 16 * 1024 + ks * 32); acc[cb] = __builtin_amdgcn_mfma_f32_16x16x32_bf16(a, bb, acc[cb], 0, 0, 0); }
        }
        __syncthreads();
#pragma unroll
        for (int i = 0; i < 4; ++i) { const int row = 4 * kq + i; const float sc = rsc[(wid >> 2) * 16 + row];
#pragma unroll
            for (int cb = 0; cb < 4; ++cb) part[wid * 1024 + row * 64 + cb * 16 + fr] = acc[cb][i] * sc; }
        __syncthreads();
        const int row = tid >> 5, cp = tid & 31;
        float s0 = 0.f, s1 = 0.f;
#pragma unroll
        for (int w = 0; w < 8; ++w) { s0 += part[w * 1024 + row * 64 + 2 * cp]; s1 += part[w * 1024 + row * 64 + 2 * cp + 1]; }
        unsigned* hp = (unsigned*)(B.H() + (size_t)(r0 + row) * DM + n0 + 2 * cp);
        const unsigned hv = *hp;
        const float v0 = __uint_as_float(hv << 16) + s0, v1 = __uint_as_float(hv & 0xffff0000u) + s1;
        *hp = pg8::cvt_pk_bf16(v0, v1);
        float ss = v0 * v0 + v1 * v1;
#pragma unroll
        for (int o = 1; o < 32; o <<= 1) ss += __shfl_xor(ss, o);
        if (cp == 0) B.ssqh()[(size_t)cg * MROWS + r0 + row] = ss;
        __syncthreads();
    }
}
__device__ __forceinline__ void phase_outproj(PG8_LAS unsigned char* lds, const Bufs& B, int l) {
    outproj_tail(lds, B, l);
    pg8::Gemm g{B.Y(), B.w3t() + (size_t)l * 1024 * 1024, MROWS - 256, 1024, 1024}; pg8::StaticOrder S; S.init(MROWS - 256, 1024, gridDim.x, blockIdx.x);
    pg8::fill_row_scalars(lds, S, RowScalarY{B.ssqy()});
    EpiOut E{B.H(), B.ssqh()}; pg8::gemm_phase(lds, g, S, E);
}

namespace att {
#define ATT_LAS __attribute__((address_space(3)))
typedef short bf16x8 __attribute__((ext_vector_type(8)));
typedef float f32x16 __attribute__((ext_vector_type(16)));
typedef short s16x4 __attribute__((ext_vector_type(4)));
typedef short v4i16_t __attribute__((ext_vector_type(4)));
typedef unsigned u32x4 __attribute__((ext_vector_type(4)));
constexpr int KBUF = 0, KTILE_MAX = 64 * 208, VBUF = 2 * KTILE_MAX, WSF = VBUF + 2 * 8192, OST = WSF + 2048, BIASL = OST + 8 * 4096, LDS_END = BIASL + BIASW * 4, UWORD = 147456 - 128;
constexpr float THR = 8.0f;
constexpr int NUNITS = 1024 + 544 + 128;
__device__ __forceinline__ int crow(int r, int hi) { return (r & 3) + 8 * (r >> 2) + 4 * hi; }
typedef float f32x2_t __attribute__((ext_vector_type(2))); typedef __bf16 bf16x2_t __attribute__((ext_vector_type(2)));
__device__ __forceinline__ unsigned cvtpk(float lo, float hi) { f32x2_t v = {lo, hi}; bf16x2_t b = __builtin_convertvector(v, bf16x2_t); return __builtin_bit_cast(unsigned, b); }
__device__ __forceinline__ s16x4 vtr(ATT_LAS const unsigned char* p) { return __builtin_bit_cast(s16x4, __builtin_amdgcn_ds_read_tr16_b64_v4i16((ATT_LAS v4i16_t*)p)); }

template <int TYPE, bool NORMALIZED = false>
__device__ __forceinline__ void attn_store(const Bufs& B, const f32x16& o0, const f32x16& o1, float lsum, int b, int h, int Pw, ATT_LAS unsigned char* lds, int wid, int lane, int wsf_off = WSF, int ost_off = OST, bool dummy = false) {
    const int r32 = lane & 31, hi = lane >> 5; const size_t rb = (size_t)b * LTOK;
    ATT_LAS float* wsf = (ATT_LAS float*)(lds + wsf_off) + wid * 64;
    if (!NORMALIZED) { lsum += __shfl_xor(lsum, 32); if (hi == 0) wsf[32 + r32] = lsum; }
    ATT_LAS bf16_t* stg = (ATT_LAS bf16_t*)(lds + ost_off + wid * 4096);
#pragma unroll
    for (int r = 0; r < 16; ++r) {
        const int qr = crow(r, hi); const float rinv = NORMALIZED ? 1.0f : __builtin_amdgcn_rcpf(wsf[32 + qr]);
        stg[qr * 64 + r32] = f2bf(o0[r] * rinv); stg[qr * 64 + 32 + r32] = f2bf(o1[r] * rinv);
    }
    const bf16_t* G = (TYPE == 0 ? B.GAS() : B.GBS());
    const int ch = lane & 7;
#pragma unroll
    for (int i = 0; i < 4; ++i) {
        const int row = i * 8 + (lane >> 3), Pr = Pw + row;
        const u32x4 ov = *(ATT_LAS const u32x4*)(stg + row * 64 + ch * 8);
        const bool ok = Pr < LTOK; const size_t grow = rb + (ok ? Pr : LTOK - 1);
        const u32x4 gv = *(const u32x4*)(G + grow * 512 + h * 64 + ch * 8);
        const unsigned ou[4] = {ov.x, ov.y, ov.z, ov.w}, gu[4] = {gv.x, gv.y, gv.z, gv.w}; unsigned yw[4]; float ss = 0.f;
#pragma unroll
        for (int j = 0; j < 4; ++j) {
            const float a0 = __uint_as_float(ou[j] << 16), a1 = __uint_as_float(ou[j] & 0xffff0000u);
            ss += a0 * a0 + a1 * a1;
            yw[j] = cvtpk(a0 * __uint_as_float(gu[j] << 16), a1 * __uint_as_float(gu[j] & 0xffff0000u));
        }
        ss += __shfl_xor(ss, 1); ss += __shfl_xor(ss, 2); ss += __shfl_xor(ss, 4);
        if (ok) {
            bf16_t* Yb = dummy ? (bf16_t*)(B.ws + WS_END) : B.Y(); float* sq = dummy ? (float*)(B.ws + WS_END + (size_t)MPAD * 2048) : B.ssqy();
            *(u32x4*)(Yb + grow * 1024 + TYPE * 512 + h * 64 + ch * 8) = (u32x4){yw[0], yw[1], yw[2], yw[3]};
            if (ch == 0) sq[(size_t)(TYPE * 8 + h) * MROWS + grow] = ss;
        }
    }
}

constexpr int B_KSLOT = 64 * 208, B_NSK = 4, B_NSV = 4, B_KRING = 0, B_VRING = B_NSK * B_KSLOT, B_DUMP = B_VRING + B_NSV * 8192, B_WSF = B_DUMP + 8192, B_OST = B_WSF + 2048, B_END = B_OST + 8 * 4096;
static_assert(B_END <= 143360, "B unit LDS map");
__device__ __forceinline__ int imin(int a, int b) { return a < b ? a : b; }
__device__ __forceinline__ void glds16(const void* gsrc, unsigned lds_dst) { unsigned keep;
    asm volatile("s_mov_b32 %0, m0\n\ts_mov_b32 m0, %2\n\ts_nop 0\n\tglobal_load_lds_dwordx4 %1, off\n\ts_mov_b32 m0, %0" : "=&s"(keep) : "v"(gsrc), "s"(lds_dst) : "memory"); }
typedef unsigned u32x2 __attribute__((ext_vector_type(2)));
__device__ __forceinline__ u32x2 gload8(const void* p) { u32x2 r; asm volatile("global_load_dwordx2 %0, %1, off" : "=v"(r) : "v"(p) : "memory"); return r; }
__device__ __forceinline__ unsigned atom_add_untracked(unsigned* p, unsigned v) { unsigned r; asm volatile("global_atomic_add %0, %1, %2, off sc0" : "=v"(r) : "v"(p), "v"(v) : "memory"); return r; }
__device__ __forceinline__ u32x4 gload16(const void* p) { u32x4 r; asm volatile("global_load_dwordx4 %0, %1, off" : "=v"(r) : "v"(p) : "memory"); return r; }
__device__ __forceinline__ float max3f(float a, float b, float c) { float r; asm("v_max3_f32 %0, %1, %2, %3" : "=v"(r) : "v"(a), "v"(b), "v"(c)); return r; }
__device__ __forceinline__ float rowmax32(const f32x16& p0, const f32x16& p1) {
    float a = max3f(p0[0], p0[1], p1[0]), b = max3f(p0[2], p0[3], p1[1]); a = max3f(a, p1[2], p1[3]);
#pragma unroll
    for (int r = 4; r < 16; r += 4) { a = max3f(a, p0[r], p0[r + 1]); b = max3f(b, p0[r + 2], p0[r + 3]); a = max3f(a, p1[r], p1[r + 1]); b = max3f(b, p1[r + 2], p1[r + 3]); }
    float m = fmaxf(a, b);
    return fmaxf(m, __shfl_xor(m, 32));
}
template <int ABL, bool HASNEXT = false>
__device__ __forceinline__ void attn_unit_b(const Bufs& B, int b, int h, int qt, ATT_LAS unsigned char* lds, unsigned* ctr, volatile ATT_LAS unsigned* uw, bool pf, bool pre = false) {
    constexpr int NKS = 6, KROWB = 208, NT = 33;
    int tid_ = threadIdx.x; asm volatile("" : "+v"(tid_));
    const int tid = tid_, lane = tid & 63, r32 = lane & 31, hi = lane >> 5, wid = __builtin_amdgcn_readfirstlane(tid >> 6);
    const int Pw = (qt < 8 ? 16 + 256 * qt : -16) + 32 * wid, P = Pw + r32, Pc = P < 0 ? 0 : (P < LTOK ? P : LTOK - 1);
    const bool wave_valid = (ABL == 6) ? false : (qt < 8 || wid == 0);
    const size_t rb = (size_t)b * LTOK, rowq = rb + Pc;
    const unsigned lds0 = (unsigned)(uintptr_t)lds;
#define B_SRC(LN_, WD_, RB_, HH_, K1_, K2_, V1_) do { \
        const int c1 = 64 * (WD_) + (LN_), kkey1 = c1 / 13, kcol1 = c1 % 13; \
        const int c2 = 64 * ((WD_) + 8) + (LN_), kkey2 = (c2 / 13) & 63, kcol2 = c2 % 13;          \
        const int vkey = 8 * (WD_) + ((LN_) >> 3), vcs = ((LN_) & 7) ^ (((vkey >> 1) & 1) << 2); \
        const bf16_t* knb = B.KNB() + (RB_) * 512 + (HH_) * 64; const bf16_t* ckr = B.CQX() + (RB_) * 512 + 256 + 128; \
        K1_ = kcol1 < 8 ? (const char*)(knb + (size_t)kkey1 * 512 + kcol1 * 8) : (const char*)(ckr + (size_t)kkey1 * 512 + ((kcol1 - 8) & 3) * 8); \
        const char* ks2 = kcol2 < 8 ? (const char*)(knb + (size_t)kkey2 * 512 + kcol2 * 8) : (const char*)(ckr + (size_t)kkey2 * 512 + ((kcol2 - 8) & 3) * 8); \
        K2_ = (WD_) < 5 ? ks2 : K1_;                           \
        V1_ = (const char*)(B.VB() + (RB_) * 512 + (HH_) * 64 + vcs * 8 + (size_t)vkey * 512); \
    } while (0)
    const char* ks1; const char* ks2x; const char* vs1;
    B_SRC(lane, wid, rb, h, ks1, ks2x, vs1);
#define B_GLDS(src, off) glds16((src), (unsigned)__builtin_amdgcn_readfirstlane((int)(lds0 + (unsigned)(off))))
#define DMA_K1(kt) B_GLDS(ks1 + (size_t)(kt) * 65536u, B_KRING + ((kt) % B_NSK) * B_KSLOT + wid * 1024)
#define DMA_K2(kt) B_GLDS(ks2x + (size_t)(kt) * 65536u, wid < 5 ? B_KRING + ((kt) % B_NSK) * B_KSLOT + (wid + 8) * 1024 : B_DUMP + wid * 1024)
#define DMA_V(kt)  B_GLDS(vs1 + (size_t)(kt) * 65536u, B_VRING + ((kt) % B_NSV) * 8192 + wid * 1024)
#define B_WAITBAR(N) do { asm volatile("s_waitcnt vmcnt(" #N ") lgkmcnt(0)" ::: "memory"); __builtin_amdgcn_s_barrier(); asm volatile("" ::: "memory"); } while (0)
    if (!pre) { DMA_K1(0); DMA_K2(0); DMA_V(0); DMA_K1(1); DMA_K2(1); DMA_V(1); DMA_K1(2); DMA_K2(2); }
    bf16x8 qf[NKS];
#pragma unroll
    for (int ks = 0; ks < NKS; ++ks) {
        const int blk = (Pw + QB_SHIFT) >> 5;
        const bf16_t* qp = (ks < 4) ? B.QBN() + qfrag_blk(b, blk, h, ks, hi, 4) + r32 * 8 : B.QBR() + qfrag_blk(b, blk, h, ks - 4, hi, 2) + r32 * 8;
        qf[ks] = *(const bf16x8*)qp;
    }
    asm volatile("" : "+v"(qf[0]), "+v"(qf[1]), "+v"(qf[2]), "+v"(qf[3]), "+v"(qf[4]), "+v"(qf[5]));
    const int q4 = (lane & 15) >> 2, p4 = lane & 3, g1 = (lane >> 4) & 1, swz = (q4 >> 1) & 1;
    const int vrd0 = (4 * hi + q4) * 128 + 32 * g1 + 8 * p4 + 64 * swz, vrd1 = (4 * hi + q4) * 128 + 32 * g1 + 8 * p4 + 64 * (1 - swz);
    const int krd = r32 * KROWB + hi * 16;
    ATT_LAS float* wsf = (ATT_LAS float*)(lds + B_WSF) + wid * 64;
    B_WAITBAR(6);
    float mhat = 0.f;
    f32x16 o0, o1, c0, c1v, lacc, negm;
#pragma unroll
    for (int r = 0; r < 16; ++r) { o0[r] = 0.f; o1[r] = 0.f; c0[r] = 0.f; c1v[r] = 0.f; lacc[r] = 0.f; negm[r] = 0.f; }
    const bf16x8 ones = (bf16x8){0x3f80, 0x3f80, 0x3f80, 0x3f80, 0x3f80, 0x3f80, 0x3f80, 0x3f80};
    if (wave_valid) {
        ATT_LAS const unsigned char* kb_ = lds + B_KRING + krd;
#pragma unroll
        for (int ks = 0; ks < NKS; ++ks) {
            const bf16x8 k0_ = *(ATT_LAS const bf16x8*)(kb_ + ks * 32), k1_ = *(ATT_LAS const bf16x8*)(kb_ + 32 * KROWB + ks * 32);
            c0 = __builtin_amdgcn_mfma_f32_32x32x16_bf16(k0_, qf[ks], c0, 0, 0, 0); c1v = __builtin_amdgcn_mfma_f32_32x32x16_bf16(k1_, qf[ks], c1v, 0, 0, 0);
        }
        asm volatile("s_nop 15\n\ts_nop 7" : "+v"(c0), "+v"(c1v));
        const float tmax = rowmax32(c0, c1v);
        mhat = tmax;
#pragma unroll
        for (int r = 0; r < 16; ++r) { c0[r] -= mhat; c1v[r] -= mhat; negm[r] = -mhat; }
    }
    asm volatile("" : "+v"(negm));
    B_WAITBAR(0);
#define SB() __builtin_amdgcn_sched_barrier(0)
#define EXP2(x) x = __builtin_amdgcn_exp2f(x)
#define B_KREADH(ks) do { kf[2 * (ks)] = *(ATT_LAS const bf16x8*)(kb_ + (ks) * 32); } while (0)
#define B_KREAD(ks) do { kf[2 * (ks)] = *(ATT_LAS const bf16x8*)(kb_ + (ks) * 32); kf[2 * (ks) + 1] = *(ATT_LAS const bf16x8*)(kb_ + 32 * KROWB + (ks) * 32); } while (0)
#define VRD(i) va[i] = vtr(vb + (((i) & 2) ? vrd1 : vrd0) + ((i) >> 2) * 2048 + ((i) & 1) * 1024)
#define PWG(g, C, base) pw[g] = (u32x4){cvtpk(C[base], C[base + 1]), cvtpk(C[base + 2], C[base + 3]), cvtpk(C[base + 4], C[base + 5]), cvtpk(C[base + 6], C[base + 7])}
#define VF0(ks) (bf16x8){va[4 * (ks)][0], va[4 * (ks)][1], va[4 * (ks)][2], va[4 * (ks)][3], va[4 * (ks) + 1][0], va[4 * (ks) + 1][1], va[4 * (ks) + 1][2], va[4 * (ks) + 1][3]}
#define VF1(ks) (bf16x8){va[4 * (ks) + 2][0], va[4 * (ks) + 2][1], va[4 * (ks) + 2][2], va[4 * (ks) + 2][3], va[4 * (ks) + 3][0], va[4 * (ks) + 3][1], va[4 * (ks) + 3][2], va[4 * (ks) + 3][3]}
#define QK0(ks) n0 = __builtin_amdgcn_mfma_f32_32x32x16_bf16(kf[2 * (ks)], qf[ks], n0, 0, 0, 0)
#define QK1(ks) n1 = __builtin_amdgcn_mfma_f32_32x32x16_bf16(kf[2 * (ks) + 1], qf[ks], n1, 0, 0, 0)
#define PVO0(ks) o0 = __builtin_amdgcn_mfma_f32_32x32x16_bf16(VF0(ks), __builtin_bit_cast(bf16x8, pw[ks]), o0, 0, 0, 0)
#define PVO1(ks) o1 = __builtin_amdgcn_mfma_f32_32x32x16_bf16(VF1(ks), __builtin_bit_cast(bf16x8, pw[ks]), o1, 0, 0, 0)
#define PVL(ks)  lacc = __builtin_amdgcn_mfma_f32_32x32x16_bf16(ones, __builtin_bit_cast(bf16x8, pw[ks]), lacc, 0, 0, 0)
#define MX3(P, lo) a_ = max3f(a_, P[lo], P[lo + 1]); b_ = max3f(b_, P[lo + 2], P[lo + 3])
#define B_ITER(T, QKF, ISSM, MSKF, ENDW, CI0, CI1, CO0, CO1, HQ, LP) do { \
        if (wave_valid) { \
            bf16x8 kf[2 * NKS]; s16x4 va[16]; u32x4 pw[4]; float a_ = 0.f, b_ = 0.f, tmax_ = 0.f; \
            ATT_LAS const unsigned char* kb_ = lds + B_KRING + (((T) + 1) % B_NSK) * B_KSLOT + krd; \
            ATT_LAS const unsigned char* vb = lds + B_VRING + ((T) % B_NSV) * 8192; \
            if (QKF) { if (HQ) { B_KREADH(0); B_KREADH(1); B_KREADH(2); } else { B_KREAD(0); B_KREAD(1); B_KREAD(2); } } \
            VRD(0); VRD(1); VRD(2); VRD(3); \
            EXP2(CI0[0]); EXP2(CI0[1]); EXP2(CI0[2]); EXP2(CI0[3]); EXP2(CI0[4]); EXP2(CI0[5]); EXP2(CI0[6]); EXP2(CI0[7]); PWG(0, CI0, 0); \
            SB(); \
            if (QKF) CO0 = __builtin_amdgcn_mfma_f32_32x32x16_bf16(kf[0], qf[0], negm, 0, 0, 0); \
            if (QKF) { if (HQ) B_KREADH(3); else B_KREAD(3); } if (!(LP)) VRD(4); if (!(LP)) EXP2(CI0[8]); if (!(LP)) EXP2(CI0[9]); SB(); \
            if (QKF && !(HQ)) CO1 = __builtin_amdgcn_mfma_f32_32x32x16_bf16(kf[1], qf[0], negm, 0, 0, 0); \
            if (!(LP)) VRD(5); if (!(LP)) EXP2(CI0[10]); if (!(LP)) EXP2(CI0[11]); SB(); \
            if (QKF) CO0 = __builtin_amdgcn_mfma_f32_32x32x16_bf16(kf[2], qf[1], CO0, 0, 0, 0); \
            if (QKF) { if (HQ) B_KREADH(4); else B_KREAD(4); } if (!(LP)) VRD(6); if (!(LP)) EXP2(CI0[12]); if (!(LP)) EXP2(CI0[13]); SB(); \
            if (QKF && !(HQ)) CO1 = __builtin_amdgcn_mfma_f32_32x32x16_bf16(kf[3], qf[1], CO1, 0, 0, 0); \
            if (!(LP)) VRD(7); if (!(LP)) EXP2(CI0[14]); if (!(LP)) EXP2(CI0[15]); SB(); \
            if (QKF) CO0 = __builtin_amdgcn_mfma_f32_32x32x16_bf16(kf[4], qf[2], CO0, 0, 0, 0); \
            if (QKF) { if (HQ) B_KREADH(5); else B_KREAD(5); } if (!(LP)) VRD(8); if (!(LP)) PWG(1, CI0, 8); SB(); \
            if (QKF && !(HQ)) CO1 = __builtin_amdgcn_mfma_f32_32x32x16_bf16(kf[5], qf[2], CO1, 0, 0, 0); \
            if (!(LP)) VRD(9); if (!(LP)) EXP2(CI1[0]); if (!(LP)) EXP2(CI1[1]); SB(); \
            if (QKF) CO0 = __builtin_amdgcn_mfma_f32_32x32x16_bf16(kf[6], qf[3], CO0, 0, 0, 0); \
            if (!(LP)) VRD(10); if (!(LP)) EXP2(CI1[2]); if (!(LP)) EXP2(CI1[3]); SB(); \
            if (QKF && !(HQ)) CO1 = __builtin_amdgcn_mfma_f32_32x32x16_bf16(kf[7], qf[3], CO1, 0, 0, 0); \
            if (!(LP)) VRD(11); if (!(LP)) EXP2(CI1[4]); if (!(LP)) EXP2(CI1[5]); SB(); \
            if (QKF) CO0 = __builtin_amdgcn_mfma_f32_32x32x16_bf16(kf[8], qf[4], CO0, 0, 0, 0); \
            if (!(LP)) VRD(12); if (!(LP)) EXP2(CI1[6]); if (!(LP)) EXP2(CI1[7]); SB(); \
            if (QKF && !(HQ)) CO1 = __builtin_amdgcn_mfma_f32_32x32x16_bf16(kf[9], qf[4], CO1, 0, 0, 0); \
            if (!(LP)) VRD(13); if (!(LP)) PWG(2, CI1, 0); SB(); \
            if (QKF) CO0 = __builtin_amdgcn_mfma_f32_32x32x16_bf16(kf[10], qf[5], CO0, 0, 0, 0); \
            if (!(LP)) VRD(14); if (!(LP)) EXP2(CI1[8]); if (!(LP)) EXP2(CI1[9]); SB(); \
            if (QKF && !(HQ)) CO1 = __builtin_amdgcn_mfma_f32_32x32x16_bf16(kf[11], qf[5], CO1, 0, 0, 0); \
            if (!(LP)) VRD(15); if (!(LP)) EXP2(CI1[10]); if (!(LP)) EXP2(CI1[11]); SB(); \
            PVO0(0); if (!(LP)) EXP2(CI1[12]); if (!(LP)) EXP2(CI1[13]); SB(); \
            PVO1(0); if (!(LP)) EXP2(CI1[14]); if (!(LP)) EXP2(CI1[15]); SB(); \
            PVL(0);  if (ISSM == 1) DMA_K1((T) + 3); SB(); \
            if (!(LP)) PVO0(1); if (!(LP)) PWG(3, CI1, 8); SB(); \
            if (!(LP)) PVO1(1); if (ISSM == 1) DMA_K2((T) + 3); SB(); \
            if (!(LP)) PVL(1);  if (ISSM >= 1) DMA_V((T) + 2); \
                     if (MSKF) { _Pragma("unroll") for (int r = 0; r < 16; ++r) { if (r >= 8) CO0[r] = -INFINITY; CO1[r] = -INFINITY; } } SB(); \
            if (!(LP)) PVO0(2); if (QKF) { a_ = max3f(CO0[0], CO0[1], CO1[0]); b_ = max3f(CO0[2], CO0[3], CO1[1]); a_ = max3f(a_, CO1[2], CO1[3]); } SB(); \
            if (!(LP)) PVO1(2); if (QKF) { MX3(CO0, 4); MX3(CO1, 4); } SB(); \
            if (!(LP)) PVL(2);  if (QKF) { MX3(CO0, 8); MX3(CO1, 8); } if (ISSM == 1) DMA_K1((T) + 4); SB(); \
            if (!(LP)) PVO0(3); if (QKF) { MX3(CO0, 12); MX3(CO1, 12); } SB(); \
            if (!(LP)) PVO1(3); if (QKF) { tmax_ = fmaxf(a_, b_); tmax_ = fmaxf(tmax_, __shfl_xor(tmax_, 32)); } if (ISSM == 1) DMA_K2((T) + 4); SB(); \
            if (!(LP)) PVL(3);  if (ISSM == 1) DMA_V((T) + 3); SB(); \
            if (QKF) { \
                if (__any(tmax_ > THR)) { \
                    const float dl = fmaxf(tmax_, 0.f), f = __builtin_amdgcn_exp2f(-dl); \
                    mhat += dl; \
                    _Pragma("unroll") for (int r = 0; r < 16; ++r) { CO0[r] -= dl; CO1[r] -= dl; negm[r] = -mhat; } \
                    asm volatile("" : "+v"(negm)); \
                    _Pragma("unroll") for (int r = 0; r < 16; ++r) { o0[r] *= f; o1[r] *= f; lacc[r] *= f; } \
                } \
            } \
        } else { \
            if (ISSM == 1) { DMA_K1((T) + 3); DMA_K2((T) + 3); DMA_V((T) + 2); DMA_K1((T) + 4); DMA_K2((T) + 4); DMA_V((T) + 3); } else if (ISSM == 2) DMA_V((T) + 2); \
        } \
        SB(); \
        ENDW; \
    } while (0)
    unsigned nxt = 0; u32x4 gp[4];
    {
        f32x16 n0, n1;
#pragma unroll
        for (int r = 0; r < 16; ++r) { n0[r] = 0.f; n1[r] = 0.f; }
        static_assert(NT == 33, "tile-loop unrolling below assumes 33 tiles");
#pragma unroll 1
        for (int t = 0; t <= 28; t += 2) { B_ITER(t, true, 1, false, asm volatile("" ::: "memory"), c0, c1v, n0, n1, false, false); B_ITER(t + 1, true, 0, false, B_WAITBAR(0), n0, n1, c0, c1v, false, false); }
        B_ITER(30, true, 2, false, asm volatile("" ::: "memory"), c0, c1v, n0, n1, false, false);
        B_ITER(31, true, 0, true, B_WAITBAR(0), n0, n1, c0, c1v, true, false);
        if (pf && tid == 0) nxt = atom_add_untracked(ctr, 1u);
#pragma unroll
        for (int i = 0; i < 4; ++i) { const int Pg = Pw + i * 8 + (lane >> 3);
            gp[i] = gload16(B.GBS() + (rb + (Pg < 0 ? 0 : (Pg < LTOK ? Pg : LTOK - 1))) * 512 + h * 64 + (lane & 7) * 8); }
        B_ITER(32, false, 0, false, asm volatile("" ::: "memory"), c0, c1v, n0, n1, false, true);
    }
    if (HASNEXT) {
        asm volatile("s_waitcnt lgkmcnt(0)" ::: "memory"); __builtin_amdgcn_s_barrier(); asm volatile("" ::: "memory");
        const char* nk1; const char* nk2; const char* nv1;
        const int nbh = b * 8 + h + 32;
        int ln2 = lane, wd2 = wid; asm volatile("" : "+v"(ln2), "+s"(wd2));
        B_SRC(ln2, wd2, (size_t)(nbh >> 3) * LTOK, (nbh & 7), nk1, nk2, nv1);
#define N_K1(kt) B_GLDS(nk1 + (size_t)(kt) * 65536u, B_KRING + ((kt) % B_NSK) * B_KSLOT + wid * 1024)
#define N_K2(kt) B_GLDS(nk2 + (size_t)(kt) * 65536u, wid < 5 ? B_KRING + ((kt) % B_NSK) * B_KSLOT + (wid + 8) * 1024 : B_DUMP + wid * 1024)
#define N_V(kt)  B_GLDS(nv1 + (size_t)(kt) * 65536u, B_VRING + ((kt) % B_NSV) * 8192 + wid * 1024)
        N_K1(0); N_K2(0); N_V(0); N_K1(1); N_K2(1); N_V(1); N_K1(2); N_K2(2);
#undef N_K1
#undef N_K2
#undef N_V
    }
#undef B_ITER
#undef MX3
#undef SB
#undef EXP2
#undef VRD
#undef PWG
#undef VF0
#undef VF1
#undef QK0
#undef QK1
#undef PVO0
#undef PVO1
#undef PVL
    if (HASNEXT) asm volatile("s_waitcnt vmcnt(8)" : "+v"(nxt), "+v"(gp[0]), "+v"(gp[1]), "+v"(gp[2]), "+v"(gp[3]) :: "memory");
    else asm volatile("s_waitcnt vmcnt(0)" : "+v"(nxt), "+v"(gp[0]), "+v"(gp[1]), "+v"(gp[2]), "+v"(gp[3]) :: "memory");
    if (wave_valid) {
        const float inv = __builtin_amdgcn_rcpf(lacc[0]); float ss = 0.f;
        ATT_LAS unsigned char* stg = lds + B_OST + wid * 4096;
        const int sw = (r32 ^ (r32 >> 3)) & 7;
#pragma unroll
        for (int i = 0; i < 8; ++i) {
            const int k = i & 3;
            const float v0 = (i < 4 ? o0[4 * k] : o1[4 * k]) * inv, v1 = (i < 4 ? o0[4 * k + 1] : o1[4 * k + 1]) * inv, v2 = (i < 4 ? o0[4 * k + 2] : o1[4 * k + 2]) * inv, v3 = (i < 4 ? o0[4 * k + 3] : o1[4 * k + 3]) * inv;
            ss += v0 * v0 + v1 * v1 + v2 * v2 + v3 * v3;
            *(ATT_LAS u32x2*)(stg + r32 * 128 + ((i ^ sw) << 4) + 8 * hi) = (u32x2){cvtpk(v0, v1), cvtpk(v2, v3)};
        }
        ss += __shfl_xor(ss, 32);
        if ((unsigned)P < (unsigned)LTOK && hi == 0) { float* sq = ABL ? (float*)(B.ws + WS_END + (size_t)MPAD * 2048) : B.ssqy(); sq[(size_t)(8 + h) * MROWS + rowq] = ss; }
        bf16_t* Yb = (ABL ? (bf16_t*)(B.ws + WS_END) : B.Y()) + 512 + h * 64 + (lane & 7) * 8;
#pragma unroll
        for (int i = 0; i < 4; ++i) {
            const int row = i * 8 + (lane >> 3), Pr = Pw + row;
            const u32x4 ov = *(ATT_LAS const u32x4*)(stg + row * 128 + (((lane & 7) ^ ((row ^ (row >> 3)) & 7)) << 4));
            const unsigned ou[4] = {ov.x, ov.y, ov.z, ov.w}, gu[4] = {gp[i].x, gp[i].y, gp[i].z, gp[i].w}; unsigned yw[4];
#pragma unroll
            for (int j = 0; j < 4; ++j) yw[j] = cvtpk(__uint_as_float(ou[j] << 16) * __uint_as_float(gu[j] << 16), __uint_as_float(ou[j] & 0xffff0000u) * __uint_as_float(gu[j] & 0xffff0000u));
            if ((unsigned)Pr < (unsigned)LTOK) *(u32x4*)(Yb + (rb + Pr) * 1024) = (u32x4){yw[0], yw[1], yw[2], yw[3]};
        }
    }
    if (pf && tid == 0) *uw = nxt;
    __syncthreads();
#undef B_VREAD
#undef B_KREAD
#undef B_KREADH
#undef B_GLDS
#undef B_SRC
#undef DMA_K1
#undef DMA_K2
#undef DMA_V
#undef B_WAITBAR
}


constexpr int A_KB = 0, A_KROW = 144, A_VB = A_KB + 384 * A_KROW, A_KM = A_VB + 384 * 128, A_VM = A_KM + 5 * 1024, A_TM = A_VM + 32 * 128, A_TR = A_TM + 4 * 1280, A_STG = A_TR + 4 * 1280, A_END = A_STG + 8 * 2048;
static_assert(A_END <= 143360, "A unit LDS map");
template <int ABL = 0>
__device__ __forceinline__ void attn_unit_a2(const Params& p, const Bufs& B, int layer, int b, int g, int qb, ATT_LAS unsigned char* lds, unsigned* ctr, volatile ATT_LAS unsigned* uw) {
    int tid_ = threadIdx.x; asm volatile("" : "+v"(tid_));
    const int tid = tid_, lane = tid & 63, r32 = lane & 31, hi = lane >> 5, wid = __builtin_amdgcn_readfirstlane(tid >> 6);
    const int hh = wid & 3, half = wid >> 2, h = 4 * g + hh;
    const size_t rb = (size_t)b * LTOK;
    const unsigned lds0 = (unsigned)(uintptr_t)lds;
    const int kbase = 128 * qb - 128;
    if (ABL == 12) { __syncthreads(); if (tid == 0) *uw = atomicAdd(ctr, 1u); __syncthreads(); return; }
    {
        const bf16_t* ka = B.KA() + rb * 128 + g * 64; const bf16_t* va_ = B.VA() + rb * 128 + g * 64;
        for (int pc = wid; pc < 54; pc += 8) { const int c = 64 * pc + lane, row = c / 9, col = c % 9; int kp = kbase + row; kp = kp < 0 ? 0 : (kp > LTOK - 1 ? LTOK - 1 : kp);
            glds16(ka + (size_t)kp * 128 + (col & 7) * 8, (unsigned)__builtin_amdgcn_readfirstlane((int)(lds0 + A_KB + pc * 1024))); }
        for (int pc = wid; pc < 48; pc += 8) { const int c = 64 * pc + lane, row = c >> 3, cs = (c & 7) ^ (((row >> 1) & 1) << 2); int kp = kbase + row; kp = kp < 0 ? 0 : (kp > LTOK - 1 ? LTOK - 1 : kp);
            glds16(va_ + (size_t)kp * 128 + cs * 8, (unsigned)__builtin_amdgcn_readfirstlane((int)(lds0 + A_VB + pc * 1024))); }
        if (wid < 5) { const int c = 64 * wid + lane, row = (c / 9) & 31, col = c % 9;
            glds16(ka + (size_t)row * 128 + (col & 7) * 8, (unsigned)__builtin_amdgcn_readfirstlane((int)(lds0 + A_KM + wid * 1024))); }
        else if (wid < 7) { const int pc = wid - 5; const int c = 64 * pc + lane, row = c >> 3, cs = (c & 7) ^ (((row >> 1) & 1) << 2);
            glds16(va_ + (size_t)row * 128 + cs * 8, (unsigned)__builtin_amdgcn_readfirstlane((int)(lds0 + A_VM + pc * 1024))); }
    }
    {
        const char* tsrc = (const char*)(B.ws + OFF_A2T) + (size_t)g * 10240 + lane * 16;
        glds16(tsrc + wid * 1024, (unsigned)__builtin_amdgcn_readfirstlane((int)(lds0 + A_TM + wid * 1024)));
        if (wid < 2) glds16(tsrc + (wid + 8) * 1024, (unsigned)__builtin_amdgcn_readfirstlane((int)(lds0 + A_TM + (wid + 8) * 1024)));
    }
    u32x4 qf_[4];
    { const int P0 = 128 * qb + 64 * half + r32, Pc0 = P0 < LTOK ? P0 : LTOK - 1;
#pragma unroll
      for (int ks = 0; ks < 4; ++ks) qf_[ks] = gload16(B.QA() + qfrag_blk(b, (P0 < LTOK ? P0 : LTOK - 1) >> 5, h, ks, hi, 4) + r32 * 8); }
    asm volatile("s_waitcnt vmcnt(0) lgkmcnt(0)" : "+v"(qf_[0]), "+v"(qf_[1]), "+v"(qf_[2]), "+v"(qf_[3]) :: "memory"); __builtin_amdgcn_s_barrier(); asm volatile("" ::: "memory");
    unsigned nxt = 0;
    const float sink2 = p.sink[layer * 8 + h] * LOG2E;
    const int q4 = (lane & 15) >> 2, p4 = lane & 3, g1 = (lane >> 4) & 1, swz = (q4 >> 1) & 1;
    const int vrd0 = (4 * hi + q4) * 128 + 32 * g1 + 8 * p4 + 64 * swz, vrd1 = (4 * hi + q4) * 128 + 32 * g1 + 8 * p4 + 64 * (1 - swz);
    const int krd = r32 * A_KROW + hi * 16;
    ATT_LAS const float* tmh = (ATT_LAS const float*)(lds + A_TM) + hh * 320; ATT_LAS const float* trh = (ATT_LAS const float*)(lds + A_TR) + hh * 320;
    ATT_LAS float* wsf = (ATT_LAS float*)(lds + A_STG + wid * 2048);
    const bf16x8 ones = (bf16x8){0x3f80, 0x3f80, 0x3f80, 0x3f80, 0x3f80, 0x3f80, 0x3f80, 0x3f80};
#pragma unroll
    for (int sbi = 0; sbi < (ABL == 11 ? 0 : 2); ++sbi) {
        const int sb = 2 * half + sbi, Pw = 128 * qb + 32 * sb;
        if (Pw >= LTOK) break;
        const int P = Pw + r32, Pc = P < LTOK ? P : LTOK - 1;
        const bf16x8 qf[4] = {__builtin_bit_cast(bf16x8, qf_[0]), __builtin_bit_cast(bf16x8, qf_[1]), __builtin_bit_cast(bf16x8, qf_[2]), __builtin_bit_cast(bf16x8, qf_[3])};
        u32x4 qn[4] = {qf_[0], qf_[1], qf_[2], qf_[3]}; u32x4 gp[4];
        const bool ok = P < LTOK; const size_t grow = rb + Pc;
        {
#pragma unroll
            for (int i = 0; i < 4; ++i) { const int Pg = Pw + (i & 1) * 16 + (lane >> 2);
                gp[i] = gload16(B.GAS() + (rb + (Pg < LTOK ? Pg : LTOK - 1)) * 512 + h * 64 + (i >> 1) * 32 + (lane & 3) * 8); }
            if (sbi == 0) { const int Pn = P + 32, Pnc = Pn < LTOK ? Pn : LTOK - 1;
#pragma unroll
                for (int ks = 0; ks < 4; ++ks) qn[ks] = gload16(B.QA() + qfrag_blk(b, Pnc >> 5, h, ks, hi, 4) + r32 * 8);
                if (tid == 0) nxt = atom_add_untracked(ctr, 1u); }
        }
        f32x16 o0, o1, lacc, negm;
#pragma unroll
        for (int r = 0; r < 16; ++r) { o0[r] = 0.f; o1[r] = 0.f; lacc[r] = 1.0f; negm[r] = -sink2; }
        asm volatile("" : "+v"(negm));
        float mhat = sink2;
#define A_SOFTPV(c, vbase, NKV) do { \
            float a_ = max3f(c[0], c[1], c[2]), b_ = max3f(c[3], c[4], c[5]); a_ = max3f(a_, c[6], c[7]); b_ = max3f(b_, c[8], c[9]); a_ = max3f(a_, c[10], c[11]); b_ = max3f(b_, c[12], c[13]); a_ = max3f(a_, c[14], c[15]); \
            float tmax = fmaxf(a_, b_); tmax = fmaxf(tmax, __shfl_xor(tmax, 32)); \
            if (__any(tmax > THR)) { const float dl = fmaxf(tmax, 0.f), f = __builtin_amdgcn_exp2f(-dl); mhat += dl; \
                _Pragma("unroll") for (int r = 0; r < 16; ++r) { c[r] -= dl; negm[r] = -mhat; } asm volatile("" : "+v"(negm)); \
                _Pragma("unroll") for (int r = 0; r < 16; ++r) { o0[r] *= f; o1[r] *= f; lacc[r] *= f; } } \
            _Pragma("unroll") for (int r = 0; r < 16; ++r) c[r] = __builtin_amdgcn_exp2f(c[r]); \
            _Pragma("unroll") for (int ks = 0; ks < NKV; ++ks) { \
                const bf16x8 pa = __builtin_bit_cast(bf16x8, (u32x4){cvtpk(c[8 * ks], c[8 * ks + 1]), cvtpk(c[8 * ks + 2], c[8 * ks + 3]), cvtpk(c[8 * ks + 4], c[8 * ks + 5]), cvtpk(c[8 * ks + 6], c[8 * ks + 7])}); \
                const s16x4 a0 = vtr((vbase) + vrd0 + ks * 2048), a1 = vtr((vbase) + vrd0 + ks * 2048 + 1024), e0 = vtr((vbase) + vrd1 + ks * 2048), e1 = vtr((vbase) + vrd1 + ks * 2048 + 1024); \
                const bf16x8 vf0 = (bf16x8){a0[0], a0[1], a0[2], a0[3], a1[0], a1[1], a1[2], a1[3]}, vf1 = (bf16x8){e0[0], e0[1], e0[2], e0[3], e1[0], e1[1], e1[2], e1[3]}; \
                o0 = __builtin_amdgcn_mfma_f32_32x32x16_bf16(vf0, pa, o0, 0, 0, 0); o1 = __builtin_amdgcn_mfma_f32_32x32x16_bf16(vf1, pa, o1, 0, 0, 0); \
                lacc = __builtin_amdgcn_mfma_f32_32x32x16_bf16(ones, pa, lacc, 0, 0, 0); } } while (0)
        {
            ATT_LAS const unsigned char* kb = lds + A_KM + krd;
            f32x16 c = __builtin_amdgcn_mfma_f32_32x32x16_bf16(*(ATT_LAS const bf16x8*)(kb), qf[0], negm, 0, 0, 0);
#pragma unroll
            for (int ks = 1; ks < 4; ++ks) c = __builtin_amdgcn_mfma_f32_32x32x16_bf16(*(ATT_LAS const bf16x8*)(kb + ks * 32), qf[ks], c, 0, 0, 0);
            const int d0 = 4 * hi - Pc;
#pragma unroll
            for (int r = 0; r < 16; ++r) { if (r < 8) { int ix = d0 + crow(r, 0) + 160; ix = ix < 0 ? 0 : ix; c[r] += trh[ix]; } else c[r] = -INFINITY; }
            A_SOFTPV(c, lds + A_VM, 1);
        }
#pragma unroll 1
        for (int j = 0; j < ((ABL == 7 || ABL == 10) ? 0 : 9); ++j) {
            const int blo = Pw - 128 + 32 * j;
            if (blo + 31 < NMETA || blo >= LTOK) continue;
            const int brow = 32 * (sb + j);
            ATT_LAS const unsigned char* kb = lds + A_KB + brow * A_KROW + krd;
            f32x16 c = __builtin_amdgcn_mfma_f32_32x32x16_bf16(*(ATT_LAS const bf16x8*)(kb), qf[0], negm, 0, 0, 0);
#pragma unroll
            for (int ks = 1; ks < 4; ++ks) c = __builtin_amdgcn_mfma_f32_32x32x16_bf16(*(ATT_LAS const bf16x8*)(kb + ks * 32), qf[ks], c, 0, 0, 0);
            const int d0 = 32 * j - 128 + 4 * hi - r32;
            ATT_LAS const float* tp = tmh + (d0 + 160);
            if (blo < NMETA || blo + 31 >= LTOK) {
#pragma unroll
                for (int r = 0; r < 16; ++r) { const int pk = blo + 4 * hi + crow(r, 0); c[r] = (pk >= NMETA && pk < LTOK) ? c[r] + tp[crow(r, 0)] : -INFINITY; }
            } else {
#pragma unroll
                for (int r = 0; r < 16; ++r) c[r] += tp[crow(r, 0)];
            }
            A_SOFTPV(c, lds + A_VB + brow * 128, 2);
        }
#undef A_SOFTPV
        asm volatile("s_waitcnt vmcnt(0)" : "+v"(gp[0]), "+v"(gp[1]), "+v"(gp[2]), "+v"(gp[3]), "+v"(qn[0]), "+v"(qn[1]), "+v"(qn[2]), "+v"(qn[3]), "+v"(nxt) :: "memory");
        if (ABL == 10) { if (o0[0] + o1[3] + lacc[2] == 12345.f) wsf[lane] = o0[1]; } else {
            const float inv = __builtin_amdgcn_rcpf(lacc[0]); float ss = 0.f;
            ATT_LAS unsigned char* stg = (ATT_LAS unsigned char*)wsf;
            const int sw = (r32 >> 2) & 3;
            bf16_t* Yb = (ABL ? (bf16_t*)(B.ws + WS_END) : B.Y()) + h * 64 + (lane & 3) * 8;
#pragma unroll
            for (int db = 0; db < 2; ++db) {
#pragma unroll
                for (int k = 0; k < 4; ++k) {
                    const float v0 = (db == 0 ? o0[4 * k] : o1[4 * k]) * inv, v1 = (db == 0 ? o0[4 * k + 1] : o1[4 * k + 1]) * inv, v2 = (db == 0 ? o0[4 * k + 2] : o1[4 * k + 2]) * inv, v3 = (db == 0 ? o0[4 * k + 3] : o1[4 * k + 3]) * inv;
                    ss += v0 * v0 + v1 * v1 + v2 * v2 + v3 * v3;
                    *(ATT_LAS u32x2*)(stg + r32 * 64 + ((k ^ sw) << 4) + 8 * hi) = (u32x2){cvtpk(v0, v1), cvtpk(v2, v3)};
                }
#pragma unroll
                for (int j = 0; j < 2; ++j) {
                    const int row = j * 16 + (lane >> 2), Pr = Pw + row;
                    const u32x4 ov = *(ATT_LAS const u32x4*)(stg + row * 64 + (((lane & 3) ^ ((row >> 2) & 3)) << 4));
                    const u32x4 gv = gp[db * 2 + j];
                    const unsigned ou[4] = {ov.x, ov.y, ov.z, ov.w}, gu[4] = {gv.x, gv.y, gv.z, gv.w}; unsigned yw[4];
#pragma unroll
                    for (int e = 0; e < 4; ++e) yw[e] = cvtpk(__uint_as_float(ou[e] << 16) * __uint_as_float(gu[e] << 16), __uint_as_float(ou[e] & 0xffff0000u) * __uint_as_float(gu[e] & 0xffff0000u));
                    if (Pr < LTOK) *(u32x4*)(Yb + (rb + Pr) * 1024 + db * 32) = (u32x4){yw[0], yw[1], yw[2], yw[3]};
                }
            }
            ss += __shfl_xor(ss, 32);
            if (ok && hi == 0) { float* sq = ABL ? (float*)(B.ws + WS_END + (size_t)MPAD * 2048) : B.ssqy(); sq[(size_t)h * MROWS + grow] = ss; }
        }
#pragma unroll
        for (int ks = 0; ks < 4; ++ks) qf_[ks] = qn[ks];
    }
    if (tid == 0) *uw = nxt;
    __syncthreads();
}

template <int ABL = 0>
__device__ __forceinline__ void attn_phase(const Params& p, const Bufs& B, int layer, ATT_LAS unsigned char* lds, int cidx = 0, int only = -1) {
    unsigned* ctr = (unsigned*)(p.ws + OFF_CTL) + 64 * (layer + 2 * cidx);
    volatile ATT_LAS unsigned* uw = (volatile ATT_LAS unsigned*)(lds + UWORD);
    const bool stat = (gridDim.x == 256);
    const bool dead_meta = (layer == 1);
    const int nst = stat ? 4 : 0, ubase = stat ? (dead_meta ? 1152 : 1024) : 0;
    const int cx = blockIdx.x & 7, cj = blockIdx.x >> 3;
    if (!stat) { if (threadIdx.x == 0) *uw = atomicAdd(ctr, 1u); __syncthreads(); }
    for (int it = 0;; ++it) {
        unsigned u; bool pf;
        if (it < nst) { u = (unsigned)(((it * 32 + cx * 4 + (cj >> 3)) << 3) + (cj & 7)); pf = (it == nst - 1); }
        else { u = ubase + *uw; pf = true; if (u >= (unsigned)NUNITS) break; }
        const bool skip = ((u < 1152) ? (only == 0) : (only == 1)) || (dead_meta && u >= 1024 && u < 1152);
        if (skip) { __syncthreads(); if (pf && threadIdx.x == 0) *uw = atomicAdd(ctr, 1u); __syncthreads(); continue; }
        if (u < 1152) { const int bh = u < 1024 ? (int)(u >> 3) : (int)u - 1024, qt = u < 1024 ? (int)(u & 7) : 8;
            const bool st_ = (it < nst) && only < 0;
            if (st_ && it + 1 < nst) attn_unit_b<ABL, true>(B, bh >> 3, bh & 7, qt, lds, ctr, uw, pf, it > 0);
            else attn_unit_b<ABL, false>(B, bh >> 3, bh & 7, qt, lds, ctr, uw, pf, st_ && it > 0); }
        else { const int i = u - 1152; int bg, qb; if (i < 512) { bg = i >> 4; qb = i & 15; } else { bg = i - 512; qb = 16; }
            attn_unit_a2<ABL>(p, B, layer, bg >> 1, bg & 1, qb, lds, ctr, uw); }
    }
}
}

__device__ __forceinline__ void phase_final(const Params& p, const Bufs& B) {
    const int lane = threadIdx.x & 63, gw = blockIdx.x * 8 + (threadIdx.x >> 6), NGW = gridDim.x * 8;
    for (int i0 = gw * 4; i0 < NBATCH * SEQ; i0 += NGW * 4) {
        uint2 hv[4][4]; float rs[4];
#pragma unroll
        for (int q = 0; q < 4; ++q) {
            const int i = i0 + q, b = i / SEQ, sq = i % SEQ, r = b * LTOK + NMETA + sq;
#pragma unroll
            for (int j = 0; j < 4; ++j) hv[q][j] = *(const uint2*)(B.H() + (size_t)r * DM + j * 256 + lane * 4);
            rs[q] = row_rs16(B.ssqh(), r, 1.0f / 1024.0f);
        }
#pragma unroll
        for (int j = 0; j < 4; ++j) {
            const int c = j * 256 + lane * 4; const float4 g = *(const float4*)(p.norm_f + c);
#pragma unroll
            for (int q = 0; q < 4; ++q) {
                float4 o; o.x = __uint_as_float(hv[q][j].x << 16) * rs[q] * g.x; o.y = __uint_as_float(hv[q][j].x & 0xffff0000u) * rs[q] * g.y;
                o.z = __uint_as_float(hv[q][j].y << 16) * rs[q] * g.z; o.w = __uint_as_float(hv[q][j].y & 0xffff0000u) * rs[q] * g.w;
                __builtin_nontemporal_store((nt_f4){o.x, o.y, o.z, o.w}, (nt_f4*)(p.out + (size_t)(i0 + q) * DM + c));
            }
        }
    }
}

constexpr int LDS_BYTES = 147456;

#define XB_TMO      128
#define XB_XCNT(j)  (256  + 64 * (j))
#define XB_XSUB(j)  (1280 + 64 * (j))
#define XB_XGEN(j)  (2304 + 64 * (j))
#define XB_TOP      3328
#define XB_TOPGEN   3392
#define XCD_BAR_WORDS 3456
#define XB_SPIN_CAP (1u << 18)
#define XB_LAS __attribute__((address_space(3)))
constexpr int BAR_WORD0 = 2048;
constexpr int LDS_BAR_OFF = 147456 - 64;
__device__ __forceinline__ unsigned xb_ld(unsigned* p)              { return __hip_atomic_load(p, __ATOMIC_RELAXED, __HIP_MEMORY_SCOPE_AGENT); }
__device__ __forceinline__ unsigned xb_add(unsigned* p, unsigned v) { return __hip_atomic_fetch_add(p, v, __ATOMIC_RELAXED, __HIP_MEMORY_SCOPE_AGENT); }
__device__ __forceinline__ unsigned xb_xcc_id() { return (unsigned)__builtin_amdgcn_s_getreg((3 << 11) | 20) & 0xFu; }
#define XB_SPIN(cond, bar) do { unsigned _sp = 0; while (cond) { __builtin_amdgcn_s_sleep(1); \
    if ((++_sp & 255u) == 0u) { if (xb_ld(&(bar)[XB_TMO])) break; if (_sp > XB_SPIN_CAP) { atomicAdd(&(bar)[XB_TMO], 1u); break; } } } } while (0)
__device__ __forceinline__ void xcd_barrier_post(unsigned* bar) { if (threadIdx.x == 0) (void)xb_add(&bar[XB_XCNT(xb_xcc_id())], 1u); }
__device__ __forceinline__ void xcd_barrier_complete(unsigned* bar, unsigned x, unsigned& nloc, unsigned& nx) {
    const unsigned G = gridDim.x * gridDim.y * gridDim.z;
    unsigned sum, cnt, mine, sp = 0u;
    for (;;) {
        sum = 0u; cnt = 0u; mine = 0u;
#pragma unroll
        for (unsigned j = 0; j < 16; ++j) { const unsigned c = xb_ld(&bar[XB_XCNT(j)]); sum += c; cnt += (c > 0u) ? 1u : 0u; mine = (j == x) ? c : mine; }
        if (sum == G) break;
        __builtin_amdgcn_s_sleep(1);
        if ((++sp & 255u) == 0u) { if (xb_ld(&bar[XB_TMO])) break; if (sp > XB_SPIN_CAP) { atomicAdd(&bar[XB_TMO], 1u); break; } }
    }
    nloc = mine > 0u ? mine : 1u; nx = cnt > 0u ? cnt : 1u;
}
__device__ __forceinline__ void xcd_barrier(unsigned* bar, volatile XB_LAS unsigned* st) {
    asm volatile("s_waitcnt vmcnt(0)" ::: "memory");
    __syncthreads();
    if (threadIdx.x == 0) {
        const unsigned x = xb_xcc_id();
        __builtin_amdgcn_s_waitcnt(0);
        unsigned nloc = st[0], nx = st[1];
        if (nloc == 0u) { xcd_barrier_complete(bar, x, nloc, nx); st[0] = nloc; st[1] = nx; }
        const unsigned old = xb_add(&bar[XB_XSUB(x)], 1u);
        const unsigned gen = old / nloc;
        if (old + 1u == (gen + 1u) * nloc) {
            __builtin_amdgcn_fence(__ATOMIC_RELEASE, "agent");
            asm volatile("s_waitcnt vmcnt(0)" ::: "memory");
            const unsigned og = xb_add(&bar[XB_TOP], 1u);
            const unsigned tg = og / nx;
            if (og + 1u == (tg + 1u) * nx) xb_add(&bar[XB_TOPGEN], 1u);
            else XB_SPIN(xb_ld(&bar[XB_TOPGEN]) == tg, bar);
            __builtin_amdgcn_fence(__ATOMIC_ACQUIRE, "agent");
            xb_add(&bar[XB_XGEN(x)], 1u);
            asm volatile("s_waitcnt vmcnt(0)" ::: "memory");
        } else {
            XB_SPIN(xb_ld(&bar[XB_XGEN(x)]) == gen, bar);
            __builtin_amdgcn_fence(__ATOMIC_ACQUIRE, "agent");
            asm volatile("s_waitcnt vmcnt(0)" ::: "memory");
        }
    }
    __syncthreads();
}

typedef const __attribute__((address_space(4))) Params* kparams_t;
__device__ __forceinline__ Params load_params() {
    kparams_t q = (kparams_t)__builtin_amdgcn_kernarg_segment_ptr(); asm volatile("" : "+s"(q));
    Params r;
    r.x = q->x; r.meta = q->meta; r.relb = q->relb; r.norm_in = q->norm_in; r.w_in = q->w_in; r.sink = q->sink; r.norm_q = q->norm_q; r.w_uq = q->w_uq;
    r.norm_kv = q->norm_kv; r.w_ukv = q->w_ukv; r.norm_oa = q->norm_oa; r.norm_ob = q->norm_ob; r.w_out = q->w_out; r.norm_f = q->norm_f; r.out = q->out; r.ws = q->ws;
    return r;
}
#if USE_CG_SYNC
#define GRID_SYNC() cg::this_grid().sync()
#else
#define GRID_SYNC() do { const Params pb_ = load_params(); xcd_barrier((unsigned*)(pb_.ws + OFF_CTL) + BAR_WORD0, (volatile XB_LAS unsigned*)((XB_LAS unsigned char*)lds_raw + LDS_BAR_OFF)); } while (0)
#endif
template <int l>
__device__ __forceinline__ void run_layer(unsigned char* lds_raw) {
    float* ldsf = (float*)lds_raw; PG8_LAS unsigned char* ldsl = (PG8_LAS unsigned char*)lds_raw;
    { const Params p = load_params(); const Bufs B = make_bufs(p.ws); phase_inproj(ldsl, p, B, l); }
    GRID_SYNC();
#if PROBE_REP == 1
    { const Params p = load_params(); const Bufs B = make_bufs(p.ws); phase_inproj(ldsl, p, B, l); }
    GRID_SYNC();
#endif
    { const Params p = load_params(); const Bufs B = make_bufs(p.ws); phase_upproj(ldsl, B, l); }
    GRID_SYNC();
#if PROBE_REP == 2
    { const Params p = load_params(); const Bufs B = make_bufs(p.ws); phase_upproj(ldsl, B, l); }
    GRID_SYNC();
#endif
    { const Params p = load_params(); const Bufs B = make_bufs(p.ws); att::attn_phase(p, B, l, ldsl); }
    GRID_SYNC();
#if PROBE_REP == 3
    { const Params p = load_params(); const Bufs B = make_bufs(p.ws); att::attn_phase(p, B, l, ldsl, 1); }
    GRID_SYNC();
#endif
#if PROBE_REP == 5 || PROBE_REP == 6
    { const Params p = load_params(); const Bufs B = make_bufs(p.ws); att::attn_phase<PROBE_ABL>(p, B, l, ldsl, 1, PROBE_REP == 5 ? 1 : 0); }
    GRID_SYNC();
#endif
#if PROBE_REP == 4
    GRID_SYNC(); GRID_SYNC(); GRID_SYNC(); GRID_SYNC(); GRID_SYNC();
#endif
    { const Params p = load_params(); const Bufs B = make_bufs(p.ws); phase_outproj(ldsl, B, l); }
    GRID_SYNC();
}
__global__ void __launch_bounds__(NTHREADS) fwd_kernel(Params p_unused) {
    extern __shared__ __attribute__((aligned(16))) unsigned char lds_raw[];
#if !USE_CG_SYNC
    if (threadIdx.x == 0) { volatile XB_LAS unsigned* st = (volatile XB_LAS unsigned*)((XB_LAS unsigned char*)lds_raw + LDS_BAR_OFF); st[0] = 0u; st[1] = 0u; }
    __syncthreads();
    { const Params p = load_params(); xcd_barrier_post((unsigned*)(p.ws + OFF_CTL) + BAR_WORD0); }
#endif
    { const Params p = load_params(); const Bufs B = make_bufs(p.ws); phase_prologue(p, B, (float*)lds_raw); }
    GRID_SYNC();
#if PROBE_REP == 7
    { const Params p = load_params(); const Bufs B = make_bufs(p.ws); phase_prologue(p, B, (float*)lds_raw); }
    GRID_SYNC();
#endif
    run_layer<0>(lds_raw);
    run_layer<1>(lds_raw);
    { const Params p = load_params(); const Bufs B = make_bufs(p.ws); phase_final(p, B); }
#if PROBE_REP == 8
    GRID_SYNC();
    { const Params p = load_params(); const Bufs B = make_bufs(p.ws); phase_final(p, B); }
#endif
}

extern "C" void kernel_launch(void* const* d_in, const int* in_sizes, int n_in, void* d_out, int out_size, void* d_ws, size_t ws_size, hipStream_t stream) {
    static int grid_blocks = 0;
    if (grid_blocks == 0) {
        if (n_in != 14 || ws_size < WS_END + (PROBE_ABL ? (size_t)MPAD * 2048 + (size_t)32 * MROWS * 4 : 0)) { fprintf(stderr, "kernel_launch: unexpected n_in %d or ws_size %zu (need %zu)\n", n_in, ws_size, (size_t)WS_END); grid_blocks = -1; return; }
        int dev = 0, cus = 0, per_cu = 0;
        hipGetDevice(&dev);
        hipDeviceGetAttribute(&cus, hipDeviceAttributeMultiprocessorCount, dev);
        hipFuncSetAttribute((const void*)fwd_kernel, hipFuncAttributeMaxDynamicSharedMemorySize, LDS_BYTES);
        hipOccupancyMaxActiveBlocksPerMultiprocessor(&per_cu, (const void*)fwd_kernel, NTHREADS, LDS_BYTES);
        if (per_cu < 1) { fprintf(stderr, "kernel_launch: occupancy query says %d blocks per CU\n", per_cu); per_cu = 1; }
        if (per_cu > 1) per_cu = 1;
        grid_blocks = cus * per_cu;
        (void)hipGetLastError();
    }
    if (grid_blocks < 0) return;
    Params p{};
    p.x = (const float*)d_in[0]; p.meta = (const float*)d_in[1]; p.relb = (const float*)d_in[2]; p.norm_in = (const float*)d_in[3]; p.w_in = (const float*)d_in[4];
    p.sink = (const float*)d_in[5]; p.norm_q = (const float*)d_in[6]; p.w_uq = (const float*)d_in[7]; p.norm_kv = (const float*)d_in[8]; p.w_ukv = (const float*)d_in[9];
    p.norm_oa = (const float*)d_in[10]; p.norm_ob = (const float*)d_in[11]; p.w_out = (const float*)d_in[12]; p.norm_f = (const float*)d_in[13];
    p.out = (float*)d_out; p.ws = (unsigned char*)d_ws;
    if (hipMemsetAsync((char*)d_ws + OFF_CTL, 0, CTL_BYTES, stream) != hipSuccess) { fprintf(stderr, "kernel_launch: memset of control words failed\n"); return; }
    void* args[] = {&p};
    hipError_t e = hipLaunchCooperativeKernel((const void*)fwd_kernel, dim3(grid_blocks), dim3(NTHREADS), args, LDS_BYTES, stream);
    if (e != hipSuccess) fprintf(stderr, "cooperative launch failed: %s (grid %d)\n", hipGetErrorString(e), grid_blocks);
}
```

```cpp
#include <hip/hip_runtime.h>
#include <hip/hip_cooperative_groups.h>
#include <cstdio>
#include <cstdint>
namespace cg = cooperative_groups;

#ifndef PROBE_REP
#define PROBE_REP 0
#endif
#ifndef PROBE_ABL
#define PROBE_ABL 0
#endif
#ifndef USE_CG_SYNC
#define USE_CG_SYNC 0
#endif
constexpr int DM = 1024, NBATCH = 16, SEQ = 2048, NMETA = 16, LTOK = SEQ + NMETA, MROWS = NBATCH * LTOK;
constexpr int MPAD = MROWS + 256;
constexpr int INW = 2208, N1 = 2304;
constexpr int NTHREADS = 512;
constexpr float EPS = 1e-6f;
constexpr float LOG2E = 1.4426950408889634f;
constexpr float QA_SCALE = 0.125f * LOG2E;
constexpr float QB_SCALE = 0.10206207261596577f * LOG2E;
constexpr int BIASW = 4128;

typedef unsigned short bf16_t;
typedef float nt_f4 __attribute__((ext_vector_type(4)));
typedef unsigned int u32;

__device__ __forceinline__ float bf2f(bf16_t v) { return __uint_as_float(((u32)v) << 16); }
__device__ __forceinline__ bf16_t f2bf(float f) { u32 u = __float_as_uint(f); u = (u + 0x7fffu + ((u >> 16) & 1u)) >> 16; return (bf16_t)u; }

constexpr size_t al256(size_t x) { return (x + 255) & ~(size_t)255; }
constexpr size_t OFF_CTL = 0;
constexpr size_t CTL_BYTES = 32768;
constexpr size_t OFF_COS = CTL_BYTES;
constexpr size_t OFF_SIN = OFF_COS + al256((size_t)LTOK * 16 * 4);
constexpr size_t OFF_BIAS = OFF_SIN + al256((size_t)LTOK * 16 * 4);
constexpr size_t OFF_A2T = OFF_BIAS + al256((size_t)8 * BIASW * 4);
constexpr size_t OFF_SSQH = OFF_A2T + al256((size_t)2 * 2560 * 4);
constexpr size_t OFF_SSQY = OFF_SSQH + al256((size_t)16 * MROWS * 4);
constexpr size_t OFF_SSQC = OFF_SSQY + al256((size_t)32 * MROWS * 4);
constexpr size_t OFF_W1T = OFF_SSQC + al256((size_t)8 * MROWS * 4);
constexpr size_t OFF_W2QT = OFF_W1T + al256((size_t)2 * N1 * 1024 * 2);
constexpr size_t OFF_W3T = OFF_W2QT + al256((size_t)2 * 1792 * 256 * 2);
constexpr size_t OFF_H = OFF_W3T + al256((size_t)2 * 1024 * 1024 * 2);
constexpr size_t OFF_QA = OFF_H + al256((size_t)MPAD * 1024 * 2);
constexpr size_t OFF_KA = OFF_QA + al256((size_t)MPAD * 512 * 2);
constexpr size_t OFF_VA = OFF_KA + al256((size_t)MPAD * 128 * 2);
constexpr size_t OFF_GAS = OFF_VA + al256((size_t)MPAD * 128 * 2);
constexpr size_t OFF_GBS = OFF_GAS + al256((size_t)MPAD * 512 * 2);
constexpr size_t OFF_CQ = OFF_GBS + al256((size_t)MPAD * 512 * 2);
constexpr size_t OFF_QBN = OFF_CQ + al256((size_t)MPAD * 512 * 2);
constexpr size_t OFF_QBR = OFF_QBN + al256((size_t)MPAD * 512 * 2);
constexpr size_t OFF_KNB = OFF_QBR + al256((size_t)MPAD * 256 * 2);
constexpr size_t OFF_VB = OFF_KNB + al256((size_t)MPAD * 512 * 2);
constexpr size_t OFF_Y = OFF_VB + al256((size_t)MPAD * 512 * 2);
constexpr size_t WS_END = OFF_Y + al256((size_t)MPAD * 1024 * 2);

struct Params {
    const float* x; const float* meta; const float* relb; const float* norm_in; const float* w_in; const float* sink; const float* norm_q; const float* w_uq;
    const float* norm_kv; const float* w_ukv; const float* norm_oa; const float* norm_ob; const float* w_out; const float* norm_f;
    float* out; unsigned char* ws;
};

struct Bufs {
    unsigned char* ws;
#define BUF_F(name, off) __device__ __forceinline__ float* name() const { return (float*)(ws + (off)); }
#define BUF_H(name, off) __device__ __forceinline__ bf16_t* name() const { return (bf16_t*)(ws + (off)); }
    BUF_F(cosT, OFF_COS) BUF_F(sinT, OFF_SIN) BUF_F(bias, OFF_BIAS) BUF_F(ssqh, OFF_SSQH) BUF_F(ssqy, OFF_SSQY) BUF_F(ssqc, OFF_SSQC)
    BUF_H(w1t, OFF_W1T) BUF_H(w2, OFF_W2QT) BUF_H(w3t, OFF_W3T) BUF_H(H, OFF_H) BUF_H(QA, OFF_QA) BUF_H(KA, OFF_KA) BUF_H(VA, OFF_VA)
    BUF_H(GAS, OFF_GAS) BUF_H(GBS, OFF_GBS) BUF_H(CQX, OFF_CQ) BUF_H(QBN, OFF_QBN) BUF_H(QBR, OFF_QBR) BUF_H(KNB, OFF_KNB) BUF_H(VB, OFF_VB) BUF_H(Y, OFF_Y)
#undef BUF_F
#undef BUF_H
};
__device__ __forceinline__ Bufs make_bufs(unsigned char* ws) { Bufs b; b.ws = ws; return b; }

__device__ __forceinline__ float wave_sum(float v) {
#pragma unroll
    for (int o = 1; o < 64; o <<= 1) v += __shfl_xor(v, o);
    return v;
}
__device__ __forceinline__ int t5_bucket(int rel) {
    const int ret = rel > 0 ? 16 : 0; const int n = rel < 0 ? -rel : rel;
    int b;
    if (n < 8) b = n;
    else b = n >= 91 ? 15 : n >= 64 ? 14 : n >= 46 ? 13 : n >= 32 ? 12 : n >= 23 ? 11 : n >= 16 ? 10 : n >= 12 ? 9 : 8;
    return ret + b;
}

__device__ __forceinline__ void transpose_item(const float* W, int ldw, const float* gain, int k0, int kvalid, int srcbase, bool perm, bool zero, bf16_t* WT, int Kd, int n0, float* scr, int lane) {
    const int c = lane & 31, sc = srcbase + (perm ? ((c >> 1) + 16 * (c & 1)) : c);
    float wv[32];
#pragma unroll
    for (int i = 0; i < 32; ++i) {
        const int k = k0 + 2 * i + (lane >> 5); const bool ok = !zero && k < kvalid; const int kc = ok ? k : 0;
        const float w = W[(size_t)kc * ldw + sc], g = gain ? gain[kc] : 1.0f;
        wv[i] = ok ? w * g : 0.f;
    }
#pragma unroll
    for (int i = 0; i < 32; ++i) scr[(2 * i + (lane >> 5)) * 33 + c] = wv[i];
    __builtin_amdgcn_s_waitcnt(0xc07f); asm volatile("" ::: "memory");
    const int c8 = lane & 7;
#pragma unroll
    for (int j = 0; j < 4; ++j) {
        const int n = (lane >> 3) + 8 * j; const float* s = scr + (8 * c8) * 33 + n;
        uint4 o;
        o.x = (u32)f2bf(s[0 * 33]) | ((u32)f2bf(s[1 * 33]) << 16); o.y = (u32)f2bf(s[2 * 33]) | ((u32)f2bf(s[3 * 33]) << 16);
        o.z = (u32)f2bf(s[4 * 33]) | ((u32)f2bf(s[5 * 33]) << 16); o.w = (u32)f2bf(s[6 * 33]) | ((u32)f2bf(s[7 * 33]) << 16);
        *(uint4*)(WT + (size_t)(n0 + n) * Kd + k0 + 8 * c8) = o;
    }
    __builtin_amdgcn_s_waitcnt(0xc07f); asm volatile("" ::: "memory");
}

__device__ __forceinline__ void phase_prologue(const Params& p, const Bufs& B, float* lds) {
    const int tid = threadIdx.x, lane = tid & 63, wave = tid >> 6;
    const int gw = blockIdx.x * 8 + wave, NGW = gridDim.x * 8;
    float* scr = lds + wave * (64 * 33);
    constexpr int I1 = 16 * 72;
    constexpr int I2 = 4 * 24;
    constexpr int I3 = 4 * 32;
    constexpr int I4 = 16 * 32;
    constexpr int IL = I1 + I2 + I3 + I4;
    for (int it = gw; it < 2 * IL; it += NGW) {
        const int l = it / IL; int r = it % IL;
        if (r < I1) {
            const int kb = r / 72, nb = r % 72, n0 = nb * 32;
            int srcbase = 0; bool perm = false, zero = false;
            if (n0 < 1280) srcbase = n0;
            else if (n0 < 1792) srcbase = 1696 + (n0 - 1280);
            else if (n0 < 2048) srcbase = 1280 + (n0 - 1792);
            else { const int j = n0 - 2048; if (j < 128) srcbase = 1536 + j; else if (j < 160) { srcbase = 1664; perm = true; } else zero = true; }
            transpose_item(p.w_in + (size_t)l * 1024 * INW, INW, p.norm_in + l * 1024, kb * 64, 1024, srcbase, perm, zero, B.w1t() + (size_t)l * N1 * 1024, 1024, n0, scr, lane);
            continue;
        }
        r -= I1;
        if (r < I2) {
            const int kb = r / 24, nb = r % 24, n0 = nb * 32;
            int srcbase; bool perm = false;
            if (n0 < 512) { const int h = n0 / 64, d0 = n0 % 64; srcbase = 96 * h + d0; }
            else { const int h = (n0 - 512) / 32; srcbase = 96 * h + 64; perm = true; }
            transpose_item(p.w_uq + (size_t)l * 256 * 768, 768, p.norm_q + l * 256, kb * 64, 256, srcbase, perm, false, B.w2() + (size_t)l * 1792 * 256, 256, n0, scr, lane);
            continue;
        }
        r -= I2;
        if (r < I3) {
            const int kb = r / 32, nb = r % 32, n0 = nb * 32;
            int srcbase;
            if (n0 < 512) { const int h = n0 / 64, d0 = n0 % 64; srcbase = 128 * h + d0; }
            else { const int j = n0 - 512, h = j / 64, d0 = j % 64; srcbase = 128 * h + 64 + d0; }
            transpose_item(p.w_ukv + (size_t)l * 128 * 1024, 1024, p.norm_kv + l * 128, kb * 64, 128, srcbase, false, false, B.w2() + (size_t)l * 1792 * 256 + (size_t)768 * 256, 256, n0, scr, lane);
            continue;
        }
        r -= I3;
        {
            const int kb = r / 32, nb = r % 32, n0 = nb * 32;
            transpose_item(p.w_out + (size_t)l * 1024 * 1024, 1024, nullptr, kb * 64, 1024, n0, false, false, B.w3t() + (size_t)l * 1024 * 1024, 1024, n0, scr, lane);
        }
    }
    for (int r0 = gw * 4; r0 < MROWS; r0 += NGW * 4) {
        float4 v[4][4];
#pragma unroll
        for (int q = 0; q < 4; ++q) {
            const int r = r0 + q, b = r / LTOK, pp = r % LTOK;
            const float* src = pp < NMETA ? p.meta + (size_t)pp * DM : p.x + ((size_t)b * SEQ + (pp - NMETA)) * DM;
#pragma unroll
            for (int j = 0; j < 4; ++j) { const nt_f4 t_ = __builtin_nontemporal_load((const nt_f4*)(src + j * 256 + lane * 4)); v[q][j] = make_float4(t_.x, t_.y, t_.z, t_.w); }
        }
#pragma unroll
        for (int q = 0; q < 4; ++q) {
            const int r = r0 + q; float s = 0.f;
#pragma unroll
            for (int j = 0; j < 4; ++j) {
                const float4 w = v[q][j];
                s += w.x * w.x + w.y * w.y + w.z * w.z + w.w * w.w;
                uint2 o; o.x = (u32)f2bf(w.x) | ((u32)f2bf(w.y) << 16); o.y = (u32)f2bf(w.z) | ((u32)f2bf(w.w) << 16);
                *(uint2*)(B.H() + (size_t)r * DM + j * 256 + lane * 4) = o;
            }
            s = wave_sum(s);
            if (lane == 0) B.ssqh()[r] = s;
        }
    }

    const int gt = blockIdx.x * NTHREADS + tid, NGT = gridDim.x * NTHREADS;
    for (int i = gt * 4; i < 15 * MROWS; i += NGT * 4) *(float4*)(B.ssqh() + MROWS + i) = make_float4(0.f, 0.f, 0.f, 0.f);
    if (gt < 1024) ((unsigned*)(p.ws + OFF_CTL))[gt] = 0u;
    for (int i = gt; i < 64 * 512 / 8; i += NGT) ((uint4*)(B.VB() + (size_t)MROWS * 512))[i] = make_uint4(0u, 0u, 0u, 0u);
    for (int i = gt; i < LTOK * 16; i += NGT) {
        const int pos = i >> 4, j = i & 15;
        const float freq = exp2f(-(float)j * (13.287712379549449f / 16.0f));
        const float ang = (float)pos * freq;
        B.cosT()[i] = cosf(ang); B.sinT()[i] = sinf(ang);
    }
    for (int i = gt; i < 8 * BIASW; i += NGT) {
        const int h = i / BIASW, rel = (i % BIASW) - LTOK;
        B.bias()[i] = p.relb[t5_bucket(rel) * 8 + h] * LOG2E;
    }
    for (int i = gt; i < 2 * 2560; i += NGT) {
        const int g = i / 2560, t = (i % 2560) / 1280, j = i % 1280, hq = j / 320, rel = (j % 320) - 160;
        const float bv = p.relb[t5_bucket(rel) * 8 + 4 * g + hq] * LOG2E;
        ((float*)(B.ws + OFF_A2T))[i] = (t == 0 && (rel < -128 || rel > 128)) ? -INFINITY : bv;
    }
}

__device__ __forceinline__ float row_rs16(const float* part, int r, float inv_n) {
    float s = 0.f;
#pragma unroll
    for (int i = 0; i < 16; ++i) s += part[(size_t)i * MROWS + r];
    return rsqrtf(s * inv_n + EPS);
}


__device__ __forceinline__ float xor32_max(float v) { const unsigned u = __float_as_uint(v); auto r = __builtin_amdgcn_permlane32_swap(u, u, false, false); return fmaxf(__uint_as_float(r[0]), __uint_as_float(r[1])); }
__device__ __forceinline__ float xor16_sum(float v) { const unsigned u = __float_as_uint(v); auto r = __builtin_amdgcn_permlane16_swap(u, u, false, false); return __uint_as_float(r[0]) + __uint_as_float(r[1]); }
__device__ __forceinline__ float xor32_sum(float v) { const unsigned u = __float_as_uint(v); auto r = __builtin_amdgcn_permlane32_swap(u, u, false, false); return __uint_as_float(r[0]) + __uint_as_float(r[1]); }
namespace pg8 {
#define PG8_LAS __attribute__((address_space(3)))
typedef short bf16x8 __attribute__((ext_vector_type(8)));
typedef float f32x4 __attribute__((ext_vector_type(4)));
typedef unsigned u32x4 __attribute__((ext_vector_type(4)));
constexpr int BM = 256, BK = 64, HALF = 128, HTB = HALF * BK * 2, STAGE_BYTES = 8 * HTB, NXCD = 8, WGM = 8;
constexpr int XTRA_OFF = STAGE_BYTES;
constexpr int MAXU = 6;

__device__ __forceinline__ int lds_byte(int r, int c) { const int st = (r >> 4) * 2 + (c >> 5), rr = r & 15, cc = c & 31, ob = rr * 64 + cc * 2; return st * 1024 + (ob ^ (((ob >> 9) & 1) << 5)); }
__device__ __forceinline__ void stage_rc(int b, int& R, int& C) { const int st = b / 1024, sb = b % 1024, swz = sb ^ (((sb >> 9) & 1) << 5); R = (st >> 1) * 16 + swz / 64; C = (st & 1) * 32 + (swz % 64) / 2; }
__device__ __forceinline__ int perm32(int rho) { const int n = rho >> 4, i = rho & 15; return 8 * (i >> 2) + 4 * n + (i & 3); }

struct Unit { int pm, pn; };
struct Gemm { const bf16_t* A; const bf16_t* Bt; int M, N, K; int lda = 0  ; int asplit = 1 << 30, aoffc = 0  , k2 = 0  ; };
struct StaticOrder {
    int nM, nN, nwg, G, c;
    __device__ void init(int M, int N, int G_, int c_) { nM = M / BM; nN = N / BM; nwg = nM * nN; G = G_; c = c_; }
    __device__ bool next(int i, Unit& u) const {
        const long L = (long)i * G + c; if (L >= nwg) return false;
        int wgid = (int)L; { const int q = nwg / NXCD, r = nwg % NXCD, xcd = wgid % NXCD, off = wgid / NXCD; wgid = (xcd < r ? xcd * (q + 1) : r * (q + 1) + (xcd - r) * q) + off; }
        const int nig = WGM * nN, gid = wgid / nig, fm = gid * WGM, gsz = (nM - fm) < WGM ? (nM - fm) : WGM;
        u.pm = fm + ((wgid % nig) % gsz); u.pn = (wgid % nig) / gsz; return true;
    }
};
__device__ __forceinline__ unsigned cvt_pk_bf16(float lo, float hi) { unsigned r; asm volatile("v_cvt_pk_bf16_f32 %0, %1, %2" : "=v"(r) : "v"(lo), "v"(hi)); return r; }

template <class Epi>
__device__ __forceinline__ void gemm_phase(PG8_LAS unsigned char* lds, const Gemm g, const StaticOrder& S, const Epi& E) {
    int tid_ = threadIdx.x; asm volatile("" : "+v"(tid_));
    const int tid = tid_, wid = __builtin_amdgcn_readfirstlane(tid >> 6), lane = tid & 63, wr = wid >> 2, wc = wid & 3, fr = lane & 15, fq = lane >> 4;
    const int K = g.K, nt = K / BK, lda = g.lda ? g.lda : g.K;
    unsigned voffA[2], voffB[2];
#pragma unroll
    for (int i = 0; i < 2; ++i) { int R, C; stage_rc(tid * 16 + i * 8192, R, C); const int Rb = Epi::PERM ? ((R & ~31) + perm32(R & 31)) : R;
        voffA[i] = (unsigned)(R * lda + C) * 2u; voffB[i] = (unsigned)(Rb * K + C) * 2u; }
    const size_t kstep = (size_t)(BK * 2);
    const size_t hstep = (size_t)HALF * K * 2, hstepA = (size_t)HALF * lda * 2;
    const size_t tstep = 2 * hstep, tstepA = 2 * hstepA;
#define PG8_ABASE(u) ((const char*)g.A + (size_t)(u).pm * tstepA + ((u).pn >= g.asplit ? (size_t)g.aoffc * 2 : (size_t)0))
    const unsigned ldsw = (unsigned)wid * 1024u;
    const int aoff = lds_byte(wr * 64 + fr, fq * 8), boff = lds_byte(wc * 32 + fr, fq * 8);
#define PG8_SA(b, h) (((b) * 2 + (h)) * HTB)
#define PG8_SB(b, h) ((4 + (b) * 2 + (h)) * HTB)
#define PG8_STAGE(bufoff, gbase, voff) do { _Pragma("unroll") for (int _i = 0; _i < 2; ++_i) \
        __builtin_amdgcn_global_load_lds((const unsigned*)((const char*)(gbase) + (voff)[_i]), (PG8_LAS unsigned*)(lds + (bufoff) + ldsw + _i * 8192), 16, 0, 0); } while (0)
#define PG8_LDA(dst, b, h) do { _Pragma("unroll") for (int m = 0; m < 4; ++m) _Pragma("unroll") for (int k = 0; k < 2; ++k) dst[m][k] = *(const PG8_LAS bf16x8*)(lds + PG8_SA(b, h) + aoff + m * 2048 + k * 1024); } while (0)
#define PG8_LDB(dst, b, h) do { _Pragma("unroll") for (int n = 0; n < 2; ++n) _Pragma("unroll") for (int k = 0; k < 2; ++k) dst[n][k] = *(const PG8_LAS bf16x8*)(lds + PG8_SB(b, h) + boff + n * 2048 + k * 1024); } while (0)
#define PG8_MMA(ai, bj, At, Bt) do { __builtin_amdgcn_s_setprio(1); _Pragma("unroll") for (int m = 0; m < 4; ++m) _Pragma("unroll") for (int n = 0; n < 2; ++n) _Pragma("unroll") for (int k = 0; k < 2; ++k) \
        acc[ai][bj][m][n] = __builtin_amdgcn_mfma_f32_16x16x32_bf16(Bt[n][k], At[m][k], acc[ai][bj][m][n], 0, 0, 0); __builtin_amdgcn_s_setprio(0); } while (0)
#define PG8_WAIT_V(n) asm volatile("s_waitcnt vmcnt(" #n ")" ::: "memory")
#define PG8_WAIT_L(n) asm volatile("s_waitcnt lgkmcnt(" #n ")" ::: "memory")
#define PG8_BAR __builtin_amdgcn_s_barrier()
#define PG8_SCHED __builtin_amdgcn_sched_barrier(0)
    Unit cur, nxt; int ui = 0;
    if (!S.next(0, cur)) return;
    f32x4 acc[2][2][4][2];
#pragma unroll
    for (int a = 0; a < 2; ++a)
#pragma unroll
        for (int b = 0; b < 2; ++b)
#pragma unroll
            for (int m = 0; m < 4; ++m)
#pragma unroll
                for (int n = 0; n < 2; ++n) acc[a][b][m][n] = (f32x4){0.f, 0.f, 0.f, 0.f};
    bf16x8 At[4][2], B0[2][2], B1[2][2];
    const char* cA = PG8_ABASE(cur); const char* cB = (const char*)g.Bt + (size_t)cur.pn * tstep;
    PG8_STAGE(PG8_SB(0, 0), cB, voffB); PG8_STAGE(PG8_SB(0, 1), cB + hstep, voffB); PG8_STAGE(PG8_SA(0, 0), cA, voffA); PG8_STAGE(PG8_SA(0, 1), cA + hstepA, voffA);
    if (wr == 1) PG8_BAR;
    PG8_WAIT_V(2); PG8_BAR;
    PG8_STAGE(PG8_SB(1, 0), cB + kstep, voffB); PG8_STAGE(PG8_SA(1, 0), cA + kstep, voffA); PG8_STAGE(PG8_SB(1, 1), cB + hstep + kstep, voffB);
    PG8_WAIT_V(6); PG8_BAR;
    for (;;) {
        const bool has_next = S.next(ui + 1, nxt);
        const char* nA = has_next ? PG8_ABASE(nxt) : cA; const char* nB = has_next ? (const char*)g.Bt + (size_t)nxt.pn * tstep : cB;
        PG8_LAS const float* xs = (PG8_LAS const float*)(lds + XTRA_OFF) + ui * 512;
        const int ntu = (g.k2 && cur.pn >= g.asplit) ? g.k2 / BK : nt;
#pragma unroll 1
        for (int t = 0; t < ntu; t += 2) {
            const bool last = (t == ntu - 2);
            const char* a1 = cA + (size_t)(t + 1) * kstep;
            const char* a2 = last ? nA : cA + (size_t)(t + 2) * kstep; const char* b2 = last ? nB : cB + (size_t)(t + 2) * kstep;
            const char* a3 = a2 + kstep; const char* b3 = b2 + kstep;
            if constexpr (Epi::HAS_MID) { if (t == (ntu >> 1)) E.mid(acc, wr, fr, xs); }
            PG8_LDB(B0, 0, 0); PG8_LDB(B1, 0, 1); PG8_SCHED; PG8_LDA(At, 0, 0); PG8_STAGE(PG8_SA(1, 1), a1 + hstepA, voffA);
            PG8_WAIT_V(8); PG8_WAIT_L(0); PG8_BAR; PG8_MMA(0, 0, At, B0); PG8_MMA(0, 1, At, B1); PG8_BAR; PG8_SCHED;
            PG8_LDA(At, 0, 1); PG8_STAGE(PG8_SB(0, 0), b2, voffB); PG8_STAGE(PG8_SB(0, 1), b2 + hstep, voffB); PG8_STAGE(PG8_SA(0, 0), a2, voffA);
            PG8_WAIT_V(8); PG8_WAIT_L(0); PG8_BAR; PG8_MMA(1, 0, At, B0); PG8_MMA(1, 1, At, B1); PG8_BAR; PG8_SCHED;
            PG8_LDB(B0, 1, 0); PG8_LDB(B1, 1, 1); PG8_SCHED; PG8_LDA(At, 1, 0); PG8_STAGE(PG8_SA(0, 1), a2 + hstepA, voffA);
            PG8_WAIT_V(8); PG8_WAIT_L(0); PG8_BAR; PG8_MMA(0, 0, At, B0); PG8_MMA(0, 1, At, B1); PG8_BAR; PG8_SCHED;
            PG8_LDA(At, 1, 1); PG8_STAGE(PG8_SB(1, 0), b3, voffB); PG8_STAGE(PG8_SB(1, 1), b3 + hstep, voffB); PG8_STAGE(PG8_SA(1, 0), a3, voffA);
            PG8_WAIT_V(8); PG8_WAIT_L(0); PG8_BAR; PG8_MMA(1, 0, At, B0); PG8_MMA(1, 1, At, B1); PG8_BAR; PG8_SCHED;
        }
        if (wr == 0) PG8_BAR;
        E(acc, cur, wr, wc, fr, fq, xs);
        if (!has_next) break;
#pragma unroll
        for (int a = 0; a < 2; ++a)
#pragma unroll
            for (int b = 0; b < 2; ++b)
#pragma unroll
                for (int m = 0; m < 4; ++m)
#pragma unroll
                    for (int n = 0; n < 2; ++n) acc[a][b][m][n] = (f32x4){0.f, 0.f, 0.f, 0.f};
        cur = nxt; cA = nA; cB = nB; ++ui;
        if (wr == 1) PG8_BAR;
    }
    PG8_WAIT_V(0);
    PG8_BAR;
#undef PG8_ABASE
#undef PG8_SA
#undef PG8_SB
#undef PG8_STAGE
#undef PG8_LDA
#undef PG8_LDB
#undef PG8_MMA
#undef PG8_WAIT_V
#undef PG8_WAIT_L
#undef PG8_BAR
#undef PG8_SCHED
}

template <class F>
__device__ __forceinline__ void fill_row_scalars(PG8_LAS unsigned char* lds, const StaticOrder& S, const F& f) {
    PG8_LAS float* xs = (PG8_LAS float*)(lds + XTRA_OFF);
    const int row = threadIdx.x & 255, half = threadIdx.x >> 8;
    StaticOrder Sl = S; asm volatile("" : "+s"(Sl.c));
    int pmv[MAXU]; bool okv[MAXU];
#pragma unroll
    for (int i = 0; i < MAXU; ++i) { Unit u; okv[i] = Sl.next(i, u); pmv[i] = okv[i] ? u.pm : 0; }
#pragma unroll
    for (int i = 1; i < MAXU; ++i) pmv[i] = okv[i] ? pmv[i] : pmv[0];
    if (F::PAIR) {
        float a[MAXU / 2], b[MAXU / 2];
#pragma unroll
        for (int q = 0; q < MAXU / 2; ++q) f.pair((half ? pmv[2 * q + 1] : pmv[2 * q]) * BM + row, a[q], b[q]);
#pragma unroll
        for (int q = 0; q < MAXU / 2; ++q) if (half ? okv[2 * q + 1] : okv[2 * q]) { xs[(2 * q + half) * 512 + row] = a[q]; xs[(2 * q + half) * 512 + 256 + row] = b[q]; }
    } else {
        float v[MAXU];
#pragma unroll
        for (int i = 0; i < MAXU; ++i) v[i] = f.one(half, pmv[i] * BM + row);
#pragma unroll
        for (int i = 0; i < MAXU; ++i) if (okv[i]) xs[i * 512 + half * 256 + row] = v[i];
    }
    __syncthreads();
}
}

__device__ __forceinline__ float fast_silu(float v) { return v * __builtin_amdgcn_rcpf(1.0f + __builtin_amdgcn_exp2f(-v * LOG2E)); }

__device__ __forceinline__ size_t qfrag_idx(size_t r, int h, int d, int nks, int sh = 0) {
    const int b = (int)(r / LTOK), P = (int)(r - (size_t)b * LTOK) + sh;
    return (((((size_t)(b * 65 + (P >> 5)) * 8 + h) * nks + (d >> 4)) * 2 + ((d >> 3) & 1)) * 32 + (P & 31)) * 8;
}
constexpr int QB_SHIFT = 16;
__device__ __forceinline__ size_t qfrag_blk(int b, int blk, int h, int ks, int hi, int nks) { return ((((size_t)(b * 65 + blk) * 8 + h) * nks + ks) * 2 + hi) * 256; }

struct EpiInProj {
    static constexpr bool PERM = true, HAS_MID = false;
    Bufs B; const float* goa; const float* gob;
    template <int KIND>
    __device__ __forceinline__ void tile(const pg8::f32x4 (&acc)[2][2][4][2], const pg8::Unit& u, int wr, int wc, int fr, int fq, PG8_LAS const float* xs) const {
        using pg8::f32x4; using pg8::u32x4; using pg8::cvt_pk_bf16;
        const int pn = u.pn, cl = wc * 32 + 8 * fq;
        const int rl0 = wr * 64 + fr; const size_t r0 = (size_t)u.pm * 256 + rl0;
        bf16_t* d0; bf16_t* d1; int ld;
        const float* gg = nullptr;
        if (KIND == 0) { ld = 512; d0 = B.QA() + r0 * 512 + pn * 256 + cl; d1 = d0 + 128; }
        else if (KIND == 1) { ld = 128; d0 = B.KA() + r0 * 128 + cl; d1 = B.VA() + r0 * 128 + cl; }
        else if (KIND == 2) { ld = 512; const int c = ((pn - 3) & 1) * 256 + cl; gg = (pn < 5 ? goa : gob) + c; d0 = (pn < 5 ? B.GAS() : B.GBS()) + r0 * 512 + c; d1 = d0 + 128; }
        else if (KIND == 3) { ld = 512; d0 = B.CQX() + r0 * 512 + cl; d1 = d0 + 128; }
        else { ld = 512; d0 = B.CQX() + r0 * 512 + 256 + cl; d1 = d0 + 128; }
        float xsv[2][4];
#pragma unroll
        for (int ai = 0; ai < 2; ++ai)
#pragma unroll
            for (int m = 0; m < 4; ++m) xsv[ai][m] = xs[rl0 + ai * 128 + m * 16];
        f32x4 g[2][2];
        if (KIND == 2) { g[0][0] = *(const f32x4*)gg; g[0][1] = *(const f32x4*)(gg + 4); g[1][0] = *(const f32x4*)(gg + 128); g[1][1] = *(const f32x4*)(gg + 132); }
        const int P0k = (int)(r0 % LTOK);
#pragma unroll
        for (int ai = 0; ai < 2; ++ai) {
            f32x4 csv[4], snv[4];
            if (KIND == 4 && wc == 0) {
#pragma unroll
                for (int m = 0; m < 4; ++m) { int pos = P0k + ai * 128 + m * 16; pos = pos >= LTOK ? pos - LTOK : pos;
                    csv[m] = *(const f32x4*)(B.cosT() + pos * 16 + 4 * fq); snv[m] = *(const f32x4*)(B.sinT() + pos * 16 + 4 * fq); }
            }
#pragma unroll
            for (int m = 0; m < 4; ++m) {
                const int ro = ai * 128 + m * 16; const float rs = xsv[ai][m];
                float ssq = 0.f;
#pragma unroll
                for (int bj = 0; bj < 2; ++bj) {
                    f32x4 v0 = acc[ai][bj][m][0] * rs, v1 = acc[ai][bj][m][1] * rs;
                    if (KIND == 0) { v0 = v0 * QA_SCALE; v1 = v1 * QA_SCALE; }
                    if (KIND == 2) {
                        const float rsn = rs * -LOG2E;
                        const f32x4 t0 = acc[ai][bj][m][0] * rsn, t1 = acc[ai][bj][m][1] * rsn;
                        f32x4 e0, e1;
#pragma unroll
                        for (int j = 0; j < 4; ++j) { e0[j] = __builtin_amdgcn_exp2f(t0[j]); e1[j] = __builtin_amdgcn_exp2f(t1[j]); }
                        e0 = e0 + 1.0f; e1 = e1 + 1.0f;
                        f32x4 s0, s1;
#pragma unroll
                        for (int j = 0; j < 4; ++j) { s0[j] = __builtin_amdgcn_rcpf(e0[j]); s1[j] = __builtin_amdgcn_rcpf(e1[j]); }
                        v0 = (v0 * g[bj][0]) * s0; v1 = (v1 * g[bj][1]) * s1;
                    }
                    if (KIND == 3 || (KIND == 4 && bj == 0))
                        ssq += (v0[0] * v0[0] + v0[1] * v0[1]) + (v0[2] * v0[2] + v0[3] * v0[3]) + (v1[0] * v1[0] + v1[1] * v1[1]) + (v1[2] * v1[2] + v1[3] * v1[3]);
                    if (KIND == 4 && bj == 1) {
                        if (wc == 0) {
                            const f32x4 cs = csv[m], sn = snv[m];
                            const f32x4 a0 = v0, a1 = v1;
                            v0[0] = a0[0] * cs[0] - a0[1] * sn[0]; v0[1] = a0[1] * cs[0] + a0[0] * sn[0]; v0[2] = a0[2] * cs[1] - a0[3] * sn[1]; v0[3] = a0[3] * cs[1] + a0[2] * sn[1];
                            v1[0] = a1[0] * cs[2] - a1[1] * sn[2]; v1[1] = a1[1] * cs[2] + a1[0] * sn[2]; v1[2] = a1[2] * cs[3] - a1[3] * sn[3]; v1[3] = a1[3] * cs[3] + a1[2] * sn[3];
                        }
                    }
                    u32x4 w; w.x = cvt_pk_bf16(v0[0], v0[1]); w.y = cvt_pk_bf16(v0[2], v0[3]); w.z = cvt_pk_bf16(v1[0], v1[1]); w.w = cvt_pk_bf16(v1[2], v1[3]);
                    if (KIND == 0) { const int c = pn * 256 + bj * 128 + cl; *(u32x4*)(B.QA() + qfrag_idx(r0 + ro, c >> 6, c & 63, 4)) = w; }
                    else *(u32x4*)((bj == 0 ? d0 : d1) + (size_t)ro * ld) = w;
                }
                if (KIND >= 3) {
                    ssq = xor16_sum(ssq); ssq = xor32_sum(ssq);
                    if (fq == 0) B.ssqc()[(size_t)((KIND - 3) * 4 + wc) * MROWS + r0 + ro] = ssq;
                }
                asm volatile("" ::: "memory");
            }
        }
    }
    __device__ __forceinline__ void operator()(const pg8::f32x4 (&acc)[2][2][4][2], const pg8::Unit& u, int wr, int wc, int fr, int fq, PG8_LAS const float* xs) const {
        const int pn = u.pn;
        if (pn < 2) tile<0>(acc, u, wr, wc, fr, fq, xs);
        else if (pn == 2) tile<1>(acc, u, wr, wc, fr, fq, xs);
        else if (pn < 7) tile<2>(acc, u, wr, wc, fr, fq, xs);
        else if (pn == 7) tile<3>(acc, u, wr, wc, fr, fq, xs);
        else tile<4>(acc, u, wr, wc, fr, fq, xs);
    }
};
struct RowScalarH { static constexpr bool PAIR = true; const float* ssqh;
    __device__ __forceinline__ void pair(int r, float& x0, float& x1) const { x0 = row_rs16(ssqh, r, 1.0f / 1024.0f); x1 = 0.f; }
    __device__ __forceinline__ float one(int, int) const { return 0.f; } };

__device__ __forceinline__ void phase_inproj(PG8_LAS unsigned char* lds, const Params& p, const Bufs& B, int l) {
    pg8::Gemm g{B.H(), B.w1t() + (size_t)l * N1 * 1024, MROWS, N1, 1024}; pg8::StaticOrder S; S.init(MROWS, N1, gridDim.x, blockIdx.x);
    pg8::fill_row_scalars(lds, S, RowScalarH{B.ssqh()});
    EpiInProj E{B, p.norm_oa + l * 512, p.norm_ob + l * 512};
    pg8::gemm_phase(lds, g, S, E);
}

__device__ __forceinline__ float rs_c(const float* ssqc, int base, int r, float inv_n) {
    const float s = ssqc[(size_t)(base + 0) * MROWS + r] + ssqc[(size_t)(base + 1) * MROWS + r] + ssqc[(size_t)(base + 2) * MROWS + r] + ssqc[(size_t)(base + 3) * MROWS + r];
    return rsqrtf(s * inv_n + EPS);
}

struct EpiUp {
    static constexpr bool PERM = true, HAS_MID = false;
    Bufs B;
    template <int WHICH>
    __device__ __forceinline__ void tile(const pg8::f32x4 (&acc)[2][2][4][2], const pg8::Unit& u, int pn, int wr, int wc, int fr, int fq, PG8_LAS const float* xs) const {
        using pg8::f32x4; using pg8::u32x4; using pg8::cvt_pk_bf16;
        const int cl = wc * 32 + 8 * fq;
        const int rl0 = wr * 64 + fr; const size_t r0 = (size_t)u.pm * 256 + rl0;
        const bool rope = (WHICH == 0 && pn == 2);
        bf16_t* d0; int ld;
        if (WHICH == 0) { if (pn < 2) { ld = 512; d0 = B.QBN() + r0 * 512 + pn * 256 + cl; } else { ld = 256; d0 = B.QBR() + r0 * 256 + cl; } }
        else { ld = 512; d0 = (pn < 2 ? B.KNB() : B.VB()) + r0 * 512 + (pn & 1) * 256 + cl; }
        const float sc = (WHICH == 0) ? QB_SCALE : 1.0f;
        float xsv[2][4];
#pragma unroll
        for (int ai = 0; ai < 2; ++ai)
#pragma unroll
            for (int m = 0; m < 4; ++m) xsv[ai][m] = xs[WHICH * 256 + rl0 + ai * 128 + m * 16];
        const int P0q = (int)(r0 % LTOK);
#pragma unroll
        for (int ai = 0; ai < 2; ++ai) {
            f32x4 csv[4], snv[4];
            if (rope) {
#pragma unroll
                for (int m = 0; m < 4; ++m) { int pos = P0q + ai * 128 + m * 16; pos = pos >= LTOK ? pos - LTOK : pos;
                    csv[m] = *(const f32x4*)(B.cosT() + pos * 16 + 4 * fq); snv[m] = *(const f32x4*)(B.sinT() + pos * 16 + 4 * fq); }
            }
#pragma unroll
            for (int m = 0; m < 4; ++m) {
                const int ro = ai * 128 + m * 16; const float rs = xsv[ai][m] * sc;
                const f32x4 cs = csv[m], sn = snv[m];
#pragma unroll
                for (int bj = 0; bj < 2; ++bj) {
                    f32x4 v0 = acc[ai][bj][m][0] * rs, v1 = acc[ai][bj][m][1] * rs;
                    if (rope) {
                        const f32x4 a0 = v0, a1 = v1;
                        v0[0] = a0[0] * cs[0] - a0[1] * sn[0]; v0[1] = a0[1] * cs[0] + a0[0] * sn[0]; v0[2] = a0[2] * cs[1] - a0[3] * sn[1]; v0[3] = a0[3] * cs[1] + a0[2] * sn[1];
                        v1[0] = a1[0] * cs[2] - a1[1] * sn[2]; v1[1] = a1[1] * cs[2] + a1[0] * sn[2]; v1[2] = a1[2] * cs[3] - a1[3] * sn[3]; v1[3] = a1[3] * cs[3] + a1[2] * sn[3];
                    }
                    u32x4 w; w.x = cvt_pk_bf16(v0[0], v0[1]); w.y = cvt_pk_bf16(v0[2], v0[3]); w.z = cvt_pk_bf16(v1[0], v1[1]); w.w = cvt_pk_bf16(v1[2], v1[3]);
                    if (WHICH == 0) { const int c = (pn < 2 ? pn * 256 : 0) + bj * 128 + cl;
                        if (pn < 2) *(u32x4*)(B.QBN() + qfrag_idx(r0 + ro, c >> 6, c & 63, 4, QB_SHIFT)) = w; else *(u32x4*)(B.QBR() + qfrag_idx(r0 + ro, c >> 5, c & 31, 2, QB_SHIFT)) = w; }
                    else *(u32x4*)(d0 + bj * 128 + (size_t)ro * ld) = w;
                }
                asm volatile("" ::: "memory");
            }
        }
    }
    __device__ __forceinline__ void operator()(const pg8::f32x4 (&acc)[2][2][4][2], const pg8::Unit& u, int wr, int wc, int fr, int fq, PG8_LAS const float* xs) const {
        if (u.pn < 3) tile<0>(acc, u, u.pn, wr, wc, fr, fq, xs); else tile<1>(acc, u, u.pn - 3, wr, wc, fr, fq, xs);
    }
};
struct RowScalarC { static constexpr bool PAIR = false; const float* ssqc;
    __device__ __forceinline__ float one(int j, int r) const { return rs_c(ssqc, 4 * j, r, j ? 1.0f / 128.0f : 1.0f / 256.0f); }
    __device__ __forceinline__ void pair(int, float&, float&) const {} };
__device__ __forceinline__ void phase_upproj(PG8_LAS unsigned char* lds, const Bufs& B, int l) {
    pg8::Gemm g{B.CQX(), B.w2() + (size_t)l * 1792 * 256, MROWS, 1792, 256, 512, 3, 256, 128}; pg8::StaticOrder S; S.init(MROWS, 1792, gridDim.x, blockIdx.x);
    pg8::fill_row_scalars(lds, S, RowScalarC{B.ssqc()});
    EpiUp E{B}; pg8::gemm_phase(lds, g, S, E);
}

struct EpiOut {
    static constexpr bool PERM = true, HAS_MID = true;
    bf16_t* H; float* ssqh;
    __device__ __forceinline__ void mid(pg8::f32x4 (&acc)[2][2][4][2], int wr, int fr, PG8_LAS const float* xs) const {
        float fv[2][4];
#pragma unroll
        for (int ai = 0; ai < 2; ++ai)
#pragma unroll
            for (int m = 0; m < 4; ++m) fv[ai][m] = xs[ai * 128 + wr * 64 + m * 16 + fr];
#pragma unroll
        for (int ai = 0; ai < 2; ++ai)
#pragma unroll
            for (int m = 0; m < 4; ++m) { const float f = fv[ai][m];
#pragma unroll
                for (int bj = 0; bj < 2; ++bj)
#pragma unroll
                    for (int n = 0; n < 2; ++n) acc[ai][bj][m][n] = acc[ai][bj][m][n] * f; }
    }
    __device__ __forceinline__ void operator()(const pg8::f32x4 (&acc)[2][2][4][2], const pg8::Unit& u, int wr, int wc, int fr, int fq, PG8_LAS const float* xs) const {
        using pg8::f32x4; using pg8::u32x4; using pg8::cvt_pk_bf16;
        const int pn = u.pn, cl = wc * 32 + 8 * fq;
        const int rl0 = wr * 64 + fr; const size_t r0 = (size_t)u.pm * 256 + rl0;
        bf16_t* d0 = H + r0 * DM + pn * 256 + cl;
        float rbv[2][4];
#pragma unroll
        for (int ai = 0; ai < 2; ++ai)
#pragma unroll
            for (int m = 0; m < 4; ++m) rbv[ai][m] = xs[256 + rl0 + ai * 128 + m * 16];
#pragma unroll
        for (int ai = 0; ai < 2; ++ai) {
            u32x4 hv[4][2];
#pragma unroll
            for (int m = 0; m < 4; ++m)
#pragma unroll
                for (int bj = 0; bj < 2; ++bj) hv[m][bj] = *(const u32x4*)(d0 + bj * 128 + (size_t)(ai * 128 + m * 16) * DM);
#pragma unroll
            for (int m = 0; m < 4; ++m) {
                const int ro = ai * 128 + m * 16; const float rb = rbv[ai][m];
                float ssq = 0.f;
#pragma unroll
                for (int bj = 0; bj < 2; ++bj) {
                    bf16_t* dp = d0 + bj * 128 + (size_t)ro * DM;
                    const u32x4 h4 = hv[m][bj];
                    f32x4 v0 = acc[ai][bj][m][0] * rb, v1 = acc[ai][bj][m][1] * rb;
                    v0[0] += __uint_as_float(h4.x << 16); v0[1] += __uint_as_float(h4.x & 0xffff0000u); v0[2] += __uint_as_float(h4.y << 16); v0[3] += __uint_as_float(h4.y & 0xffff0000u);
                    v1[0] += __uint_as_float(h4.z << 16); v1[1] += __uint_as_float(h4.z & 0xffff0000u); v1[2] += __uint_as_float(h4.w << 16); v1[3] += __uint_as_float(h4.w & 0xffff0000u);
                    ssq += (v0[0] * v0[0] + v0[1] * v0[1]) + (v0[2] * v0[2] + v0[3] * v0[3]) + (v1[0] * v1[0] + v1[1] * v1[1]) + (v1[2] * v1[2] + v1[3] * v1[3]);
                    u32x4 w; w.x = cvt_pk_bf16(v0[0], v0[1]); w.y = cvt_pk_bf16(v0[2], v0[3]); w.z = cvt_pk_bf16(v1[0], v1[1]); w.w = cvt_pk_bf16(v1[2], v1[3]);
                    *(u32x4*)dp = w;
                }
                ssq = xor16_sum(ssq); ssq = xor32_sum(ssq);
                if (fq == 0) ssqh[(size_t)(pn * 4 + wc) * MROWS + r0 + ro] = ssq;
            }
            asm volatile("" ::: "memory");
        }
    }
};
struct RowScalarY {
    static constexpr bool PAIR = true;
    const float* ssqy;
    __device__ __forceinline__ void pair(int r, float& x0, float& x1) const {
        float sa = 0.f, sb = 0.f;
#pragma unroll
        for (int i = 0; i < 8; ++i) { sa += ssqy[(size_t)i * MROWS + r]; sb += ssqy[(size_t)(8 + i) * MROWS + r]; }
        const float ra = rsqrtf(sa * (1.0f / 512.0f) + EPS), rb = rsqrtf(sb * (1.0f / 512.0f) + EPS);
        x0 = ra / rb; x1 = rb;
    }
    __device__ __forceinline__ float one(int, int) const { return 0.f; }
};
__device__ __forceinline__ void outproj_tail(PG8_LAS unsigned char* lds, const Bufs& B, int l) {
    typedef short bf16x8 __attribute__((ext_vector_type(8))); typedef float f32x4 __attribute__((ext_vector_type(4)));
    for (int c = blockIdx.x; c < 256; c += gridDim.x) {
        int tid_ = threadIdx.x; asm volatile("" : "+v"(tid_));
        const int tid = tid_, lane = tid & 63, wid = __builtin_amdgcn_readfirstlane(tid >> 6);
        const int rg = c >> 4, cg = c & 15, r0 = (MROWS - 256) + 16 * rg, n0 = 64 * cg;
        PG8_LAS float* part = (PG8_LAS float*)lds;
        PG8_LAS float* rsc = part + 8 * 1024;
        if (tid < 32) {
            const int row = tid & 15, j = tid >> 4; float sa = 0.f;
#pragma unroll
            for (int i = 0; i < 8; ++i) sa += B.ssqy()[(size_t)(8 * j + i) * MROWS + r0 + row];
            rsc[j * 16 + row] = rsqrtf(sa * (1.0f / 512.0f) + EPS);
        }
        const int fr = lane & 15, kq = lane >> 4;
        const int row = tid >> 5, cp = tid & 31;
        unsigned* hp = (unsigned*)(B.H() + (size_t)(r0 + row) * DM + n0 + 2 * cp);
        const unsigned hv = *hp;
        f32x4 acc[4];
#pragma unroll
        for (int cb = 0; cb < 4; ++cb) acc[cb] = (f32x4){0.f, 0.f, 0.f, 0.f};
        const bf16_t* Ap = B.Y() + (size_t)(r0 + fr) * 1024 + wid * 128 + kq * 8;
        const bf16_t* Bp = B.w3t() + (size_t)l * 1024 * 1024 + (size_t)(n0 + fr) * 1024 + wid * 128 + kq * 8;
#pragma unroll
        for (int ks = 0; ks < 4; ++ks) {
            const bf16x8 a = *(const bf16x8*)(Ap + ks * 32);
#pragma unroll
            for (int cb = 0; cb < 4; ++cb) { const bf16x8 bb = *(const bf16x8*)(Bp + (size_t)cb * 16 * 1024 + ks * 32); acc[cb] = __builtin_amdgcn_mfma_f32_16x16x32_bf16(a, bb, acc[cb], 0, 0, 0); }
        }
        __syncthreads();
#pragma unroll
        for (int i = 0; i < 4; ++i) { const int row = 4 * kq + i; const float sc = rsc[(wid >> 2) * 16 + row];
#pragma unroll
            for (int cb = 0; cb < 4; ++cb) part[wid * 1024 + row * 64 + cb * 16 + fr] = acc[cb][i] * sc; }
        __syncthreads();
        float s0 = 0.f, s1 = 0.f;
#pragma unroll
        for (int w = 0; w < 8; ++w) { s0 += part[w * 1024 + row * 64 + 2 * cp]; s1 += part[w * 1024 + row * 64 + 2 * cp + 1]; }
        const float v0 = __uint_as_float(hv << 16) + s0, v1 = __uint_as_float(hv & 0xffff0000u) + s1;
        *hp = pg8::cvt_pk_bf16(v0, v1);
        float ss = v0 * v0 + v1 * v1;
#pragma unroll
        for (int o = 1; o < 32; o <<= 1) ss += __shfl_xor(ss, o);
        if (cp == 0) B.ssqh()[(size_t)cg * MROWS + r0 + row] = ss;
        __syncthreads();
    }
}
__device__ __forceinline__ void phase_outproj(PG8_LAS unsigned char* lds, const Bufs& B, int l) {
    outproj_tail(lds, B, l);
    pg8::Gemm g{B.Y(), B.w3t() + (size_t)l * 1024 * 1024, MROWS - 256, 1024, 1024}; pg8::StaticOrder S; S.init(MROWS - 256, 1024, gridDim.x, blockIdx.x);
    pg8::fill_row_scalars(lds, S, RowScalarY{B.ssqy()});
    EpiOut E{B.H(), B.ssqh()}; pg8::gemm_phase(lds, g, S, E);
}

namespace att {
#define ATT_LAS __attribute__((address_space(3)))
typedef short bf16x8 __attribute__((ext_vector_type(8)));
typedef float f32x16 __attribute__((ext_vector_type(16)));
typedef short s16x4 __attribute__((ext_vector_type(4)));
typedef short v4i16_t __attribute__((ext_vector_type(4)));
typedef unsigned u32x4 __attribute__((ext_vector_type(4)));
constexpr int KBUF = 0, KTILE_MAX = 64 * 208, VBUF = 2 * KTILE_MAX, WSF = VBUF + 2 * 8192, OST = WSF + 2048, BIASL = OST + 8 * 4096, LDS_END = BIASL + BIASW * 4, UWORD = 147456 - 128;
constexpr float THR = 8.0f;
constexpr int NUNITS = 1024 + 544 + 128;
__device__ __forceinline__ int crow(int r, int hi) { return (r & 3) + 8 * (r >> 2) + 4 * hi; }
typedef float f32x2_t __attribute__((ext_vector_type(2))); typedef __bf16 bf16x2_t __attribute__((ext_vector_type(2)));
__device__ __forceinline__ unsigned cvtpk(float lo, float hi) { f32x2_t v = {lo, hi}; bf16x2_t b = __builtin_convertvector(v, bf16x2_t); return __builtin_bit_cast(unsigned, b); }
__device__ __forceinline__ s16x4 vtr(ATT_LAS const unsigned char* p) { return __builtin_bit_cast(s16x4, __builtin_amdgcn_ds_read_tr16_b64_v4i16((ATT_LAS v4i16_t*)p)); }

template <int TYPE, bool NORMALIZED = false>
__device__ __forceinline__ void attn_store(const Bufs& B, const f32x16& o0, const f32x16& o1, float lsum, int b, int h, int Pw, ATT_LAS unsigned char* lds, int wid, int lane, int wsf_off = WSF, int ost_off = OST, bool dummy = false) {
    const int r32 = lane & 31, hi = lane >> 5; const size_t rb = (size_t)b * LTOK;
    ATT_LAS float* wsf = (ATT_LAS float*)(lds + wsf_off) + wid * 64;
    if (!NORMALIZED) { lsum += __shfl_xor(lsum, 32); if (hi == 0) wsf[32 + r32] = lsum; }
    ATT_LAS bf16_t* stg = (ATT_LAS bf16_t*)(lds + ost_off + wid * 4096);
#pragma unroll
    for (int r = 0; r < 16; ++r) {
        const int qr = crow(r, hi); const float rinv = NORMALIZED ? 1.0f : __builtin_amdgcn_rcpf(wsf[32 + qr]);
        stg[qr * 64 + r32] = f2bf(o0[r] * rinv); stg[qr * 64 + 32 + r32] = f2bf(o1[r] * rinv);
    }
    const bf16_t* G = (TYPE == 0 ? B.GAS() : B.GBS());
    const int ch = lane & 7;
#pragma unroll
    for (int i = 0; i < 4; ++i) {
        const int row = i * 8 + (lane >> 3), Pr = Pw + row;
        const u32x4 ov = *(ATT_LAS const u32x4*)(stg + row * 64 + ch * 8);
        const bool ok = Pr < LTOK; const size_t grow = rb + (ok ? Pr : LTOK - 1);
        const u32x4 gv = *(const u32x4*)(G + grow * 512 + h * 64 + ch * 8);
        const unsigned ou[4] = {ov.x, ov.y, ov.z, ov.w}, gu[4] = {gv.x, gv.y, gv.z, gv.w}; unsigned yw[4]; float ss = 0.f;
#pragma unroll
        for (int j = 0; j < 4; ++j) {
            const float a0 = __uint_as_float(ou[j] << 16), a1 = __uint_as_float(ou[j] & 0xffff0000u);
            ss += a0 * a0 + a1 * a1;
            yw[j] = cvtpk(a0 * __uint_as_float(gu[j] << 16), a1 * __uint_as_float(gu[j] & 0xffff0000u));
        }
        ss += __shfl_xor(ss, 1); ss += __shfl_xor(ss, 2); ss += __shfl_xor(ss, 4);
        if (ok) {
            bf16_t* Yb = dummy ? (bf16_t*)(B.ws + WS_END) : B.Y(); float* sq = dummy ? (float*)(B.ws + WS_END + (size_t)MPAD * 2048) : B.ssqy();
            *(u32x4*)(Yb + grow * 1024 + TYPE * 512 + h * 64 + ch * 8) = (u32x4){yw[0], yw[1], yw[2], yw[3]};
            if (ch == 0) sq[(size_t)(TYPE * 8 + h) * MROWS + grow] = ss;
        }
    }
}

constexpr int B_KSLOT = 64 * 208, B_NSK = 4, B_NSV = 4, B_KRING = 0, B_VRING = B_NSK * B_KSLOT, B_DUMP = B_VRING + B_NSV * 8192, B_WSF = B_DUMP + 8192, B_OST = B_WSF + 2048, B_END = B_OST + 8 * 4096;
static_assert(B_END <= 143360, "B unit LDS map");
__device__ __forceinline__ int imin(int a, int b) { return a < b ? a : b; }
__device__ __forceinline__ void glds16(const void* gsrc, unsigned lds_dst) { unsigned keep;
    asm volatile("s_mov_b32 %0, m0\n\ts_mov_b32 m0, %2\n\ts_nop 0\n\tglobal_load_lds_dwordx4 %1, off\n\ts_mov_b32 m0, %0" : "=&s"(keep) : "v"(gsrc), "s"(lds_dst) : "memory"); }
typedef unsigned u32x2 __attribute__((ext_vector_type(2)));
__device__ __forceinline__ u32x2 gload8(const void* p) { u32x2 r; asm volatile("global_load_dwordx2 %0, %1, off" : "=v"(r) : "v"(p) : "memory"); return r; }
__device__ __forceinline__ unsigned atom_add_untracked(unsigned* p, unsigned v) { unsigned r; asm volatile("global_atomic_add %0, %1, %2, off sc0" : "=v"(r) : "v"(p), "v"(v) : "memory"); return r; }
__device__ __forceinline__ void gstore16_wt(void* p, u32x4 v) { asm volatile("global_store_dwordx4 %0, %1, off sc1\n\ts_nop 1" :: "v"(p), "v"(v) : "memory"); }
__device__ __forceinline__ u32x4 gload16_nt(const void* p) { u32x4 r; asm volatile("global_load_dwordx4 %0, %1, off nt" : "=v"(r) : "v"(p) : "memory"); return r; }
__device__ __forceinline__ u32x4 gload16(const void* p) { u32x4 r; asm volatile("global_load_dwordx4 %0, %1, off" : "=v"(r) : "v"(p) : "memory"); return r; }
__device__ __forceinline__ float max3f(float a, float b, float c) { float r; asm("v_max3_f32 %0, %1, %2, %3" : "=v"(r) : "v"(a), "v"(b), "v"(c)); return r; }
__device__ __forceinline__ float rowmax32(const f32x16& p0, const f32x16& p1) {
    float a = max3f(p0[0], p0[1], p1[0]), b = max3f(p0[2], p0[3], p1[1]); a = max3f(a, p1[2], p1[3]);
#pragma unroll
    for (int r = 4; r < 16; r += 4) { a = max3f(a, p0[r], p0[r + 1]); b = max3f(b, p0[r + 2], p0[r + 3]); a = max3f(a, p1[r], p1[r + 1]); b = max3f(b, p1[r + 2], p1[r + 3]); }
    float m = fmaxf(a, b);
    return xor32_max(m);
}
template <int ABL, bool HASNEXT = false>
__device__ __forceinline__ void attn_unit_b(const Bufs& B, int b, int h, int qt, ATT_LAS unsigned char* lds, unsigned* ctr, volatile ATT_LAS unsigned* uw, bool pf, bool pre = false) {
    constexpr int NKS = 6, KROWB = 208, NT = 33;
    int tid_ = threadIdx.x; asm volatile("" : "+v"(tid_));
    const int tid = tid_, lane = tid & 63, r32 = lane & 31, hi = lane >> 5, wid = __builtin_amdgcn_readfirstlane(tid >> 6);
    const int Pw = (qt < 8 ? 16 + 256 * qt : -16) + 32 * wid, P = Pw + r32, Pc = P < 0 ? 0 : (P < LTOK ? P : LTOK - 1);
    const bool wave_valid = (ABL == 6) ? false : (qt < 8 || wid == 0);
    const size_t rb = (size_t)b * LTOK, rowq = rb + Pc;
    const unsigned lds0 = (unsigned)(uintptr_t)lds;
#define B_SRC(LN_, WD_, RB_, HH_, K1_, K2_, V1_) do { \
        const int c1 = 64 * (WD_) + (LN_), kkey1 = c1 / 13, kcol1 = c1 % 13; \
        const int c2 = 64 * ((WD_) + 8) + (LN_), kkey2 = (c2 / 13) & 63, kcol2 = c2 % 13;          \
        const int vkey = 8 * (WD_) + ((LN_) >> 3), vcs = ((LN_) & 7) ^ (((vkey >> 1) & 1) << 2); \
        const bf16_t* knb = B.KNB() + (RB_) * 512 + (HH_) * 64; const bf16_t* ckr = B.CQX() + (RB_) * 512 + 256 + 128; \
        K1_ = kcol1 < 8 ? (const char*)(knb + (size_t)kkey1 * 512 + kcol1 * 8) : (const char*)(ckr + (size_t)kkey1 * 512 + ((kcol1 - 8) & 3) * 8); \
        const char* ks2 = kcol2 < 8 ? (const char*)(knb + (size_t)kkey2 * 512 + kcol2 * 8) : (const char*)(ckr + (size_t)kkey2 * 512 + ((kcol2 - 8) & 3) * 8); \
        K2_ = (WD_) < 5 ? ks2 : (const char*)knb;              \
        V1_ = (const char*)(B.VB() + (RB_) * 512 + (HH_) * 64 + vcs * 8 + (size_t)vkey * 512); \
    } while (0)
    const char* ks1; const char* ks2x; const char* vs1;
    B_SRC(lane, wid, rb, h, ks1, ks2x, vs1);
#define B_GLDS(src, off) glds16((src), (unsigned)__builtin_amdgcn_readfirstlane((int)(lds0 + (unsigned)(off))))
#define DMA_K1(kt) B_GLDS(ks1 + (size_t)(kt) * 65536u, B_KRING + ((kt) % B_NSK) * B_KSLOT + wid * 1024)
#define DMA_K2(kt) B_GLDS(ks2x + (size_t)(kt) * 65536u, wid < 5 ? B_KRING + ((kt) % B_NSK) * B_KSLOT + (wid + 8) * 1024 : B_DUMP + wid * 1024)
#define DMA_V(kt)  B_GLDS(vs1 + (size_t)(kt) * 65536u, B_VRING + ((kt) % B_NSV) * 8192 + wid * 1024)
#define B_WAITBAR(N) do { asm volatile("s_waitcnt vmcnt(" #N ") lgkmcnt(0)" ::: "memory"); __builtin_amdgcn_s_barrier(); asm volatile("" ::: "memory"); } while (0)
    if (!pre) { DMA_K1(0); DMA_K2(0); DMA_V(0); DMA_K1(1); DMA_K2(1); DMA_V(1); DMA_K1(2); DMA_K2(2); }
    bf16x8 qf[NKS];
#pragma unroll
    for (int ks = 0; ks < NKS; ++ks) {
        const int blk = (Pw + QB_SHIFT) >> 5;
        const bf16_t* qp = (ks < 4) ? B.QBN() + qfrag_blk(b, blk, h, ks, hi, 4) + r32 * 8 : B.QBR() + qfrag_blk(b, blk, h, ks - 4, hi, 2) + r32 * 8;
        qf[ks] = *(const bf16x8*)qp;
    }
    asm volatile("" : "+v"(qf[0]), "+v"(qf[1]), "+v"(qf[2]), "+v"(qf[3]), "+v"(qf[4]), "+v"(qf[5]));
    const int q4 = (lane & 15) >> 2, p4 = lane & 3, g1 = (lane >> 4) & 1, swz = (q4 >> 1) & 1;
    const int vrd0 = (4 * hi + q4) * 128 + 32 * g1 + 8 * p4 + 64 * swz, vrd1 = (4 * hi + q4) * 128 + 32 * g1 + 8 * p4 + 64 * (1 - swz);
    const int krd = r32 * KROWB + hi * 16;
    ATT_LAS float* wsf = (ATT_LAS float*)(lds + B_WSF) + wid * 64;
    B_WAITBAR(6);
    float mhat = 0.f;
    f32x16 o0, o1, c0, c1v, lacc, negm;
#pragma unroll
    for (int r = 0; r < 16; ++r) { o0[r] = 0.f; o1[r] = 0.f; c0[r] = 0.f; c1v[r] = 0.f; lacc[r] = 0.f; negm[r] = 0.f; }
    const bf16x8 ones = (bf16x8){0x3f80, 0x3f80, 0x3f80, 0x3f80, 0x3f80, 0x3f80, 0x3f80, 0x3f80};
    if (wave_valid) {
        ATT_LAS const unsigned char* kb_ = lds + B_KRING + krd;
#pragma unroll
        for (int ks = 0; ks < NKS; ++ks) {
            const bf16x8 k0_ = *(ATT_LAS const bf16x8*)(kb_ + ks * 32), k1_ = *(ATT_LAS const bf16x8*)(kb_ + 32 * KROWB + ks * 32);
            c0 = __builtin_amdgcn_mfma_f32_32x32x16_bf16(k0_, qf[ks], c0, 0, 0, 0); c1v = __builtin_amdgcn_mfma_f32_32x32x16_bf16(k1_, qf[ks], c1v, 0, 0, 0);
        }
        asm volatile("s_nop 15\n\ts_nop 7" : "+v"(c0), "+v"(c1v));
        const float tmax = rowmax32(c0, c1v);
        mhat = tmax;
#pragma unroll
        for (int r = 0; r < 16; ++r) { c0[r] -= mhat; c1v[r] -= mhat; negm[r] = -mhat; }
    }
    asm volatile("" : "+v"(negm));
    B_WAITBAR(0);
#define SB() __builtin_amdgcn_sched_barrier(0)
#define EXP2(x) x = __builtin_amdgcn_exp2f(x)
#define B_KREADH(ks) do { kf[2 * (ks)] = *(ATT_LAS const bf16x8*)(kb_ + (ks) * 32); } while (0)
#define B_KREADN(ks) do { kf[2 * (ks)] = *(ATT_LAS const bf16x8*)(kbn_ + (ks) * 32); kf[2 * (ks) + 1] = *(ATT_LAS const bf16x8*)(kbn_ + 32 * KROWB + (ks) * 32); } while (0)
#define B_KREAD(ks) do { kf[2 * (ks)] = *(ATT_LAS const bf16x8*)(kb_ + (ks) * 32); kf[2 * (ks) + 1] = *(ATT_LAS const bf16x8*)(kb_ + 32 * KROWB + (ks) * 32); } while (0)
#define VRD(i) va[i] = vtr(vb + (((i) & 2) ? vrd1 : vrd0) + ((i) >> 2) * 2048 + ((i) & 1) * 1024)
#define PWG(g, C, base) pw[g] = (u32x4){cvtpk(C[base], C[base + 1]), cvtpk(C[base + 2], C[base + 3]), cvtpk(C[base + 4], C[base + 5]), cvtpk(C[base + 6], C[base + 7])}
#define VF0(ks) (bf16x8){va[4 * (ks)][0], va[4 * (ks)][1], va[4 * (ks)][2], va[4 * (ks)][3], va[4 * (ks) + 1][0], va[4 * (ks) + 1][1], va[4 * (ks) + 1][2], va[4 * (ks) + 1][3]}
#define VF1(ks) (bf16x8){va[4 * (ks) + 2][0], va[4 * (ks) + 2][1], va[4 * (ks) + 2][2], va[4 * (ks) + 2][3], va[4 * (ks) + 3][0], va[4 * (ks) + 3][1], va[4 * (ks) + 3][2], va[4 * (ks) + 3][3]}
#define QK0(ks) n0 = __builtin_amdgcn_mfma_f32_32x32x16_bf16(kf[2 * (ks)], qf[ks], n0, 0, 0, 0)
#define QK1(ks) n1 = __builtin_amdgcn_mfma_f32_32x32x16_bf16(kf[2 * (ks) + 1], qf[ks], n1, 0, 0, 0)
#define PVO0(ks) o0 = __builtin_amdgcn_mfma_f32_32x32x16_bf16(VF0(ks), __builtin_bit_cast(bf16x8, pw[ks]), o0, 0, 0, 0)
#define PVO1(ks) o1 = __builtin_amdgcn_mfma_f32_32x32x16_bf16(VF1(ks), __builtin_bit_cast(bf16x8, pw[ks]), o1, 0, 0, 0)
#define PVL(ks)  lacc = __builtin_amdgcn_mfma_f32_32x32x16_bf16(ones, __builtin_bit_cast(bf16x8, pw[ks]), lacc, 0, 0, 0)
#define MX3(P, lo) a_ = max3f(a_, P[lo], P[lo + 1]); b_ = max3f(b_, P[lo + 2], P[lo + 3])
#define B_ITER(T, QKF, ISSM, MSKF, ENDW, CI0, CI1, CO0, CO1, HQ, LP, KPRE, KNEXT) do { \
        if (wave_valid) { \
            s16x4 va[16]; u32x4 pw[4]; float a_ = 0.f, b_ = 0.f, tmax_ = 0.f; \
            ATT_LAS const unsigned char* kb_ = lds + B_KRING + (((T) + 1) % B_NSK) * B_KSLOT + krd; \
            ATT_LAS const unsigned char* kbn_ = lds + B_KRING + (((T) + 2) % B_NSK) * B_KSLOT + krd; \
            ATT_LAS const unsigned char* vb = lds + B_VRING + ((T) % B_NSV) * 8192; \
            if (QKF) { if (HQ) { B_KREADH(0); B_KREADH(1); B_KREADH(2); } else { if (!(KPRE)) B_KREAD(0); B_KREAD(1); B_KREAD(2); } } \
            VRD(0); VRD(1); VRD(2); VRD(3); \
            EXP2(CI0[0]); EXP2(CI0[1]); EXP2(CI0[2]); EXP2(CI0[3]); EXP2(CI0[4]); EXP2(CI0[5]); EXP2(CI0[6]); EXP2(CI0[7]); PWG(0, CI0, 0); \
            SB(); \
            if (QKF) CO0 = __builtin_amdgcn_mfma_f32_32x32x16_bf16(kf[0], qf[0], negm, 0, 0, 0); \
            if (QKF) { if (HQ) B_KREADH(3); else B_KREAD(3); } if (!(LP)) VRD(4); if (!(LP)) EXP2(CI0[8]); if (!(LP)) EXP2(CI0[9]); SB(); \
            if (QKF && !(HQ)) CO1 = __builtin_amdgcn_mfma_f32_32x32x16_bf16(kf[1], qf[0], negm, 0, 0, 0); \
            if (!(LP)) VRD(5); if (!(LP)) EXP2(CI0[10]); if (!(LP)) EXP2(CI0[11]); SB(); \
            if (QKF) CO0 = __builtin_amdgcn_mfma_f32_32x32x16_bf16(kf[2], qf[1], CO0, 0, 0, 0); \
            if (QKF) { if (HQ) B_KREADH(4); else B_KREAD(4); } if (!(LP)) VRD(6); if (!(LP)) EXP2(CI0[12]); if (!(LP)) EXP2(CI0[13]); SB(); \
            if (QKF && !(HQ)) CO1 = __builtin_amdgcn_mfma_f32_32x32x16_bf16(kf[3], qf[1], CO1, 0, 0, 0); \
            if (!(LP)) VRD(7); if (!(LP)) EXP2(CI0[14]); if (!(LP)) EXP2(CI0[15]); SB(); \
            if (QKF) CO0 = __builtin_amdgcn_mfma_f32_32x32x16_bf16(kf[4], qf[2], CO0, 0, 0, 0); \
            if (QKF) { if (HQ) B_KREADH(5); else B_KREAD(5); } if (!(LP)) VRD(8); if (!(LP)) PWG(1, CI0, 8); SB(); \
            if (QKF && !(HQ)) CO1 = __builtin_amdgcn_mfma_f32_32x32x16_bf16(kf[5], qf[2], CO1, 0, 0, 0); \
            if (!(LP)) VRD(9); if (!(LP)) EXP2(CI1[0]); if (!(LP)) EXP2(CI1[1]); SB(); \
            if (QKF) CO0 = __builtin_amdgcn_mfma_f32_32x32x16_bf16(kf[6], qf[3], CO0, 0, 0, 0); \
            if (!(LP)) VRD(10); if (!(LP)) EXP2(CI1[2]); if (!(LP)) EXP2(CI1[3]); SB(); \
            if (QKF && !(HQ)) CO1 = __builtin_amdgcn_mfma_f32_32x32x16_bf16(kf[7], qf[3], CO1, 0, 0, 0); \
            if (!(LP)) VRD(11); if (!(LP)) EXP2(CI1[4]); if (!(LP)) EXP2(CI1[5]); SB(); \
            if (QKF) CO0 = __builtin_amdgcn_mfma_f32_32x32x16_bf16(kf[8], qf[4], CO0, 0, 0, 0); \
            if (!(LP)) VRD(12); if (!(LP)) EXP2(CI1[6]); if (!(LP)) EXP2(CI1[7]); SB(); \
            if (QKF && !(HQ)) CO1 = __builtin_amdgcn_mfma_f32_32x32x16_bf16(kf[9], qf[4], CO1, 0, 0, 0); \
            if (!(LP)) VRD(13); if (!(LP)) PWG(2, CI1, 0); SB(); \
            if (QKF) CO0 = __builtin_amdgcn_mfma_f32_32x32x16_bf16(kf[10], qf[5], CO0, 0, 0, 0); \
            if (!(LP)) VRD(14); if (!(LP)) EXP2(CI1[8]); if (!(LP)) EXP2(CI1[9]); SB(); \
            if (QKF && !(HQ)) CO1 = __builtin_amdgcn_mfma_f32_32x32x16_bf16(kf[11], qf[5], CO1, 0, 0, 0); \
            if (!(LP)) VRD(15); if (!(LP)) EXP2(CI1[10]); if (!(LP)) EXP2(CI1[11]); SB(); \
            PVO0(0); if (!(LP)) EXP2(CI1[12]); if (!(LP)) EXP2(CI1[13]); SB(); \
            PVO1(0); if (!(LP)) EXP2(CI1[14]); if (!(LP)) EXP2(CI1[15]); SB(); \
            PVL(0);  if (ISSM == 1) DMA_K1((T) + 3); SB(); \
            if (!(LP)) PVO0(1); if (!(LP)) PWG(3, CI1, 8); SB(); \
            if (!(LP)) PVO1(1); if (ISSM == 1) DMA_K2((T) + 3); SB(); \
            if (!(LP)) PVL(1);  if (ISSM >= 1) DMA_V((T) + 2); \
                     if (MSKF) { _Pragma("unroll") for (int r = 0; r < 16; ++r) { if (r >= 8) CO0[r] = -INFINITY; CO1[r] = -INFINITY; } } SB(); \
            if (!(LP)) PVO0(2); if (QKF) { a_ = max3f(CO0[0], CO0[1], CO1[0]); b_ = max3f(CO0[2], CO0[3], CO1[1]); a_ = max3f(a_, CO1[2], CO1[3]); } SB(); \
            if (!(LP)) PVO1(2); if (QKF) { MX3(CO0, 4); MX3(CO1, 4); } SB(); \
            if (!(LP)) PVL(2);  if (QKF) { MX3(CO0, 8); MX3(CO1, 8); } if (ISSM == 1) DMA_K1((T) + 4); SB(); \
            if (!(LP)) PVO0(3); if (QKF) { MX3(CO0, 12); MX3(CO1, 12); } SB(); \
            if (!(LP)) PVO1(3); if (QKF) { tmax_ = xor32_max(fmaxf(a_, b_)); } if (ISSM == 1) DMA_K2((T) + 4); if (KNEXT) { B_KREADN(0); } SB(); \
            if (!(LP)) PVL(3);  if (ISSM == 1) DMA_V((T) + 3); SB(); \
            if (QKF) { \
                if (__any(tmax_ > THR)) { \
                    const float dl = fmaxf(tmax_, 0.f), f = __builtin_amdgcn_exp2f(-dl); \
                    mhat += dl; \
                    _Pragma("unroll") for (int r = 0; r < 16; ++r) { CO0[r] -= dl; CO1[r] -= dl; negm[r] = -mhat; } \
                    asm volatile("" : "+v"(negm)); \
                    _Pragma("unroll") for (int r = 0; r < 16; ++r) { o0[r] *= f; o1[r] *= f; lacc[r] *= f; } \
                } \
            } \
        } else { \
            if (ISSM == 1) { DMA_K1((T) + 3); DMA_K2((T) + 3); DMA_V((T) + 2); DMA_K1((T) + 4); DMA_K2((T) + 4); DMA_V((T) + 3); } else if (ISSM == 2) DMA_V((T) + 2); \
        } \
        SB(); \
        ENDW; \
    } while (0)
    unsigned nxt = 0; u32x4 gp[4];
    {
        f32x16 n0, n1; bf16x8 kf[2 * NKS];
#pragma unroll
        for (int r = 0; r < 16; ++r) { n0[r] = 0.f; n1[r] = 0.f; }
        static_assert(NT == 33, "tile-loop unrolling below assumes 33 tiles");
#pragma unroll 1
        for (int t = 0; t <= 28; t += 2) { B_ITER(t, true, 1, false, asm volatile("" ::: "memory"), c0, c1v, n0, n1, false, false, false, true); B_ITER(t + 1, true, 0, false, B_WAITBAR(0), n0, n1, c0, c1v, false, false, true, false); }
        B_ITER(30, true, 2, false, asm volatile("" ::: "memory"), c0, c1v, n0, n1, false, false, false, false);
        B_ITER(31, true, 0, true, B_WAITBAR(0), n0, n1, c0, c1v, true, false, false, false);
        if (pf && tid == 0) nxt = atom_add_untracked(ctr, 1u);
#pragma unroll
        for (int i = 0; i < 4; ++i) { const int Pg = Pw + i * 8 + (lane >> 3);
            gp[i] = gload16_nt(B.GBS() + (rb + (Pg < 0 ? 0 : (Pg < LTOK ? Pg : LTOK - 1))) * 512 + h * 64 + (lane & 7) * 8); }
        B_ITER(32, false, 0, false, asm volatile("" ::: "memory"), c0, c1v, n0, n1, false, true, false, false);
    }
    if (HASNEXT) {
        asm volatile("s_waitcnt lgkmcnt(0)" ::: "memory"); __builtin_amdgcn_s_barrier(); asm volatile("" ::: "memory");
        const char* nk1; const char* nk2; const char* nv1;
        const int nbh = b * 8 + h + 32;
        int ln2 = lane, wd2 = wid; asm volatile("" : "+v"(ln2), "+s"(wd2));
        B_SRC(ln2, wd2, (size_t)(nbh >> 3) * LTOK, (nbh & 7), nk1, nk2, nv1);
#define N_K1(kt) B_GLDS(nk1 + (size_t)(kt) * 65536u, B_KRING + ((kt) % B_NSK) * B_KSLOT + wid * 1024)
#define N_K2(kt) B_GLDS(nk2 + (size_t)(kt) * 65536u, wid < 5 ? B_KRING + ((kt) % B_NSK) * B_KSLOT + (wid + 8) * 1024 : B_DUMP + wid * 1024)
#define N_V(kt)  B_GLDS(nv1 + (size_t)(kt) * 65536u, B_VRING + ((kt) % B_NSV) * 8192 + wid * 1024)
        N_K1(0); N_K2(0); N_V(0); N_K1(1); N_K2(1); N_V(1); N_K1(2); N_K2(2);
#undef N_K1
#undef N_K2
#undef N_V
    }
#undef B_ITER
#undef MX3
#undef SB
#undef EXP2
#undef VRD
#undef PWG
#undef VF0
#undef VF1
#undef QK0
#undef QK1
#undef PVO0
#undef PVO1
#undef PVL
    if (HASNEXT) asm volatile("s_waitcnt vmcnt(8)" : "+v"(nxt), "+v"(gp[0]), "+v"(gp[1]), "+v"(gp[2]), "+v"(gp[3]) :: "memory");
    else asm volatile("s_waitcnt vmcnt(0)" : "+v"(nxt), "+v"(gp[0]), "+v"(gp[1]), "+v"(gp[2]), "+v"(gp[3]) :: "memory");
    if (wave_valid) {
        const float inv = __builtin_amdgcn_rcpf(lacc[0]); float ss = 0.f;
        ATT_LAS unsigned char* stg = lds + B_OST + wid * 4096;
        const int sw = (r32 ^ (r32 >> 3)) & 7;
#pragma unroll
        for (int i = 0; i < 8; ++i) {
            const int k = i & 3;
            const float v0 = (i < 4 ? o0[4 * k] : o1[4 * k]) * inv, v1 = (i < 4 ? o0[4 * k + 1] : o1[4 * k + 1]) * inv, v2 = (i < 4 ? o0[4 * k + 2] : o1[4 * k + 2]) * inv, v3 = (i < 4 ? o0[4 * k + 3] : o1[4 * k + 3]) * inv;
            ss += v0 * v0 + v1 * v1 + v2 * v2 + v3 * v3;
            *(ATT_LAS u32x2*)(stg + r32 * 128 + ((i ^ sw) << 4) + 8 * hi) = (u32x2){cvtpk(v0, v1), cvtpk(v2, v3)};
        }
        ss = xor32_sum(ss);
        if ((unsigned)P < (unsigned)LTOK && hi == 0) { float* sq = ABL ? (float*)(B.ws + WS_END + (size_t)MPAD * 2048) : B.ssqy(); sq[(size_t)(8 + h) * MROWS + rowq] = ss; }
        bf16_t* Yb = (ABL ? (bf16_t*)(B.ws + WS_END) : B.Y()) + 512 + h * 64 + (lane & 7) * 8;
#pragma unroll
        for (int i = 0; i < 4; ++i) {
            const int row = i * 8 + (lane >> 3), Pr = Pw + row;
            const u32x4 ov = *(ATT_LAS const u32x4*)(stg + row * 128 + (((lane & 7) ^ ((row ^ (row >> 3)) & 7)) << 4));
            const unsigned ou[4] = {ov.x, ov.y, ov.z, ov.w}, gu[4] = {gp[i].x, gp[i].y, gp[i].z, gp[i].w}; unsigned yw[4];
#pragma unroll
            for (int j = 0; j < 4; ++j) yw[j] = cvtpk(__uint_as_float(ou[j] << 16) * __uint_as_float(gu[j] << 16), __uint_as_float(ou[j] & 0xffff0000u) * __uint_as_float(gu[j] & 0xffff0000u));
            if ((unsigned)Pr < (unsigned)LTOK) gstore16_wt(Yb + (rb + Pr) * 1024, (u32x4){yw[0], yw[1], yw[2], yw[3]});
        }
    }
    if (pf && tid == 0) *uw = nxt;
    __syncthreads();
#undef B_VREAD
#undef B_KREAD
#undef B_KREADN
#undef B_KREADH
#undef B_GLDS
#undef B_SRC
#undef DMA_K1
#undef DMA_K2
#undef DMA_V
#undef B_WAITBAR
}


constexpr int A_KB = 0, A_KROW = 144, A_VB = A_KB + 384 * A_KROW, A_KM = A_VB + 384 * 128, A_VM = A_KM + 5 * 1024, A_TM = A_VM + 32 * 128, A_TR = A_TM + 4 * 1280, A_STG = A_TR + 4 * 1280, A_END = A_STG + 8 * 2048;
static_assert(A_END <= 143360, "A unit LDS map");
template <int ABL = 0>
__device__ __forceinline__ void attn_unit_a2(const Params& p, const Bufs& B, int layer, int b, int g, int qb, ATT_LAS unsigned char* lds, unsigned* ctr, volatile ATT_LAS unsigned* uw) {
    int tid_ = threadIdx.x; asm volatile("" : "+v"(tid_));
    const int tid = tid_, lane = tid & 63, r32 = lane & 31, hi = lane >> 5, wid = __builtin_amdgcn_readfirstlane(tid >> 6);
    const int hh = wid & 3, half = wid >> 2, h = 4 * g + hh;
    const size_t rb = (size_t)b * LTOK;
    const unsigned lds0 = (unsigned)(uintptr_t)lds;
    const int kbase = 128 * qb - 128;
    if (ABL == 12) { __syncthreads(); if (tid == 0) *uw = atomicAdd(ctr, 1u); __syncthreads(); return; }
    const float sink2 = p.sink[layer * 8 + h] * LOG2E;
    {
        const bf16_t* ka = B.KA() + rb * 128 + g * 64; const bf16_t* va_ = B.VA() + rb * 128 + g * 64;
        for (int pc = wid; pc < 54; pc += 8) { const int c = 64 * pc + lane, row = c / 9, col = c % 9; int kp = kbase + row; kp = kp < 0 ? 0 : (kp > LTOK - 1 ? LTOK - 1 : kp);
            glds16(ka + (size_t)kp * 128 + (col & 7) * 8, (unsigned)__builtin_amdgcn_readfirstlane((int)(lds0 + A_KB + pc * 1024))); }
        for (int pc = wid; pc < 48; pc += 8) { const int c = 64 * pc + lane, row = c >> 3, cs = (c & 7) ^ (((row >> 1) & 1) << 2); int kp = kbase + row; kp = kp < 0 ? 0 : (kp > LTOK - 1 ? LTOK - 1 : kp);
            glds16(va_ + (size_t)kp * 128 + cs * 8, (unsigned)__builtin_amdgcn_readfirstlane((int)(lds0 + A_VB + pc * 1024))); }
        if (wid < 5) { const int c = 64 * wid + lane, row = (c / 9) & 31, col = c % 9;
            glds16(ka + (size_t)row * 128 + (col & 7) * 8, (unsigned)__builtin_amdgcn_readfirstlane((int)(lds0 + A_KM + wid * 1024))); }
        else if (wid < 7) { const int pc = wid - 5; const int c = 64 * pc + lane, row = c >> 3, cs = (c & 7) ^ (((row >> 1) & 1) << 2);
            glds16(va_ + (size_t)row * 128 + cs * 8, (unsigned)__builtin_amdgcn_readfirstlane((int)(lds0 + A_VM + pc * 1024))); }
    }
    {
        const char* tsrc = (const char*)(B.ws + OFF_A2T) + (size_t)g * 10240 + lane * 16;
        glds16(tsrc + wid * 1024, (unsigned)__builtin_amdgcn_readfirstlane((int)(lds0 + A_TM + wid * 1024)));
        if (wid < 2) glds16(tsrc + (wid + 8) * 1024, (unsigned)__builtin_amdgcn_readfirstlane((int)(lds0 + A_TM + (wid + 8) * 1024)));
    }
    u32x4 qf_[4];
    { const int P0 = 128 * qb + 64 * half + r32, Pc0 = P0 < LTOK ? P0 : LTOK - 1;
#pragma unroll
      for (int ks = 0; ks < 4; ++ks) qf_[ks] = gload16(B.QA() + qfrag_blk(b, (P0 < LTOK ? P0 : LTOK - 1) >> 5, h, ks, hi, 4) + r32 * 8); }
    asm volatile("s_waitcnt vmcnt(0) lgkmcnt(0)" : "+v"(qf_[0]), "+v"(qf_[1]), "+v"(qf_[2]), "+v"(qf_[3]) :: "memory"); __builtin_amdgcn_s_barrier(); asm volatile("" ::: "memory");
    unsigned nxt = 0;
    const int q4 = (lane & 15) >> 2, p4 = lane & 3, g1 = (lane >> 4) & 1, swz = (q4 >> 1) & 1;
    const int vrd0 = (4 * hi + q4) * 128 + 32 * g1 + 8 * p4 + 64 * swz, vrd1 = (4 * hi + q4) * 128 + 32 * g1 + 8 * p4 + 64 * (1 - swz);
    const int krd = r32 * A_KROW + hi * 16;
    ATT_LAS const float* tmh = (ATT_LAS const float*)(lds + A_TM) + hh * 320; ATT_LAS const float* trh = (ATT_LAS const float*)(lds + A_TR) + hh * 320;
    ATT_LAS float* wsf = (ATT_LAS float*)(lds + A_STG + wid * 2048);
    const bf16x8 ones = (bf16x8){0x3f80, 0x3f80, 0x3f80, 0x3f80, 0x3f80, 0x3f80, 0x3f80, 0x3f80};
#pragma unroll
    for (int sbi = 0; sbi < (ABL == 11 ? 0 : 2); ++sbi) {
        const int sb = 2 * half + sbi, Pw = 128 * qb + 32 * sb;
        if (Pw >= LTOK) break;
        const int P = Pw + r32, Pc = P < LTOK ? P : LTOK - 1;
        const bf16x8 qf[4] = {__builtin_bit_cast(bf16x8, qf_[0]), __builtin_bit_cast(bf16x8, qf_[1]), __builtin_bit_cast(bf16x8, qf_[2]), __builtin_bit_cast(bf16x8, qf_[3])};
        u32x4 qn[4] = {qf_[0], qf_[1], qf_[2], qf_[3]}; u32x4 gp[4];
        const bool ok = P < LTOK; const size_t grow = rb + Pc;
        {
#pragma unroll
            for (int i = 0; i < 4; ++i) { const int Pg = Pw + (i & 1) * 16 + (lane >> 2);
                gp[i] = gload16_nt(B.GAS() + (rb + (Pg < LTOK ? Pg : LTOK - 1)) * 512 + h * 64 + (i >> 1) * 32 + (lane & 3) * 8); }
            if (sbi == 0) { const int Pn = P + 32, Pnc = Pn < LTOK ? Pn : LTOK - 1;
#pragma unroll
                for (int ks = 0; ks < 4; ++ks) qn[ks] = gload16(B.QA() + qfrag_blk(b, Pnc >> 5, h, ks, hi, 4) + r32 * 8);
                if (tid == 0) nxt = atom_add_untracked(ctr, 1u); }
        }
        f32x16 o0, o1, lacc, negm;
#pragma unroll
        for (int r = 0; r < 16; ++r) { o0[r] = 0.f; o1[r] = 0.f; lacc[r] = 1.0f; negm[r] = -sink2; }
        asm volatile("" : "+v"(negm));
        float mhat = sink2;
#define A_SOFTPV(c, vbase, NKV) do { \
            float a_ = max3f(c[0], c[1], c[2]), b_ = max3f(c[3], c[4], c[5]); a_ = max3f(a_, c[6], c[7]); b_ = max3f(b_, c[8], c[9]); a_ = max3f(a_, c[10], c[11]); b_ = max3f(b_, c[12], c[13]); a_ = max3f(a_, c[14], c[15]); \
            float tmax = xor32_max(fmaxf(a_, b_)); \
            if (__any(tmax > THR)) { const float dl = fmaxf(tmax, 0.f), f = __builtin_amdgcn_exp2f(-dl); mhat += dl; \
                _Pragma("unroll") for (int r = 0; r < 16; ++r) { c[r] -= dl; negm[r] = -mhat; } asm volatile("" : "+v"(negm)); \
                _Pragma("unroll") for (int r = 0; r < 16; ++r) { o0[r] *= f; o1[r] *= f; lacc[r] *= f; } } \
            _Pragma("unroll") for (int r = 0; r < 16; ++r) c[r] = __builtin_amdgcn_exp2f(c[r]); \
            _Pragma("unroll") for (int ks = 0; ks < NKV; ++ks) { \
                const bf16x8 pa = __builtin_bit_cast(bf16x8, (u32x4){cvtpk(c[8 * ks], c[8 * ks + 1]), cvtpk(c[8 * ks + 2], c[8 * ks + 3]), cvtpk(c[8 * ks + 4], c[8 * ks + 5]), cvtpk(c[8 * ks + 6], c[8 * ks + 7])}); \
                const s16x4 a0 = vtr((vbase) + vrd0 + ks * 2048), a1 = vtr((vbase) + vrd0 + ks * 2048 + 1024), e0 = vtr((vbase) + vrd1 + ks * 2048), e1 = vtr((vbase) + vrd1 + ks * 2048 + 1024); \
                const bf16x8 vf0 = (bf16x8){a0[0], a0[1], a0[2], a0[3], a1[0], a1[1], a1[2], a1[3]}, vf1 = (bf16x8){e0[0], e0[1], e0[2], e0[3], e1[0], e1[1], e1[2], e1[3]}; \
                o0 = __builtin_amdgcn_mfma_f32_32x32x16_bf16(vf0, pa, o0, 0, 0, 0); o1 = __builtin_amdgcn_mfma_f32_32x32x16_bf16(vf1, pa, o1, 0, 0, 0); \
                lacc = __builtin_amdgcn_mfma_f32_32x32x16_bf16(ones, pa, lacc, 0, 0, 0); } } while (0)
#define A_SOFTPV_PRE(c, VA) do { \
            float a_ = max3f(c[0], c[1], c[2]), b_ = max3f(c[3], c[4], c[5]); a_ = max3f(a_, c[6], c[7]); b_ = max3f(b_, c[8], c[9]); a_ = max3f(a_, c[10], c[11]); b_ = max3f(b_, c[12], c[13]); a_ = max3f(a_, c[14], c[15]); \
            float tmax = xor32_max(fmaxf(a_, b_)); \
            if (__any(tmax > THR)) { const float dl = fmaxf(tmax, 0.f), f = __builtin_amdgcn_exp2f(-dl); mhat += dl; \
                _Pragma("unroll") for (int r = 0; r < 16; ++r) { c[r] -= dl; negm[r] = -mhat; } asm volatile("" : "+v"(negm)); \
                _Pragma("unroll") for (int r = 0; r < 16; ++r) { o0[r] *= f; o1[r] *= f; lacc[r] *= f; } } \
            _Pragma("unroll") for (int r = 0; r < 16; ++r) c[r] = __builtin_amdgcn_exp2f(c[r]); \
            _Pragma("unroll") for (int ks = 0; ks < 2; ++ks) { \
                const bf16x8 pa = __builtin_bit_cast(bf16x8, (u32x4){cvtpk(c[8 * ks], c[8 * ks + 1]), cvtpk(c[8 * ks + 2], c[8 * ks + 3]), cvtpk(c[8 * ks + 4], c[8 * ks + 5]), cvtpk(c[8 * ks + 6], c[8 * ks + 7])}); \
                const s16x4 a0 = VA[4 * ks], a1 = VA[4 * ks + 1], e0 = VA[4 * ks + 2], e1 = VA[4 * ks + 3]; \
                const bf16x8 vf0 = (bf16x8){a0[0], a0[1], a0[2], a0[3], a1[0], a1[1], a1[2], a1[3]}, vf1 = (bf16x8){e0[0], e0[1], e0[2], e0[3], e1[0], e1[1], e1[2], e1[3]}; \
                o0 = __builtin_amdgcn_mfma_f32_32x32x16_bf16(vf0, pa, o0, 0, 0, 0); o1 = __builtin_amdgcn_mfma_f32_32x32x16_bf16(vf1, pa, o1, 0, 0, 0); \
                lacc = __builtin_amdgcn_mfma_f32_32x32x16_bf16(ones, pa, lacc, 0, 0, 0); } } while (0)
        {
            ATT_LAS const unsigned char* kb = lds + A_KM + krd;
            f32x16 c = __builtin_amdgcn_mfma_f32_32x32x16_bf16(*(ATT_LAS const bf16x8*)(kb), qf[0], negm, 0, 0, 0);
#pragma unroll
            for (int ks = 1; ks < 4; ++ks) c = __builtin_amdgcn_mfma_f32_32x32x16_bf16(*(ATT_LAS const bf16x8*)(kb + ks * 32), qf[ks], c, 0, 0, 0);
            const int d0 = 4 * hi - Pc;
#pragma unroll
            for (int r = 0; r < 16; ++r) { if (r < 8) { int ix = d0 + crow(r, 0) + 160; ix = ix < 0 ? 0 : ix; c[r] += trh[ix]; } else c[r] = -INFINITY; }
            A_SOFTPV(c, lds + A_VM, 1);
        }
#pragma unroll 1
        for (int j = 0; j < ((ABL == 7 || ABL == 10) ? 0 : 9); ++j) {
            const int blo = Pw - 128 + 32 * j;
            if (blo + 31 < NMETA || blo >= LTOK) continue;
            const int brow = 32 * (sb + j);
            ATT_LAS const unsigned char* kb = lds + A_KB + brow * A_KROW + krd;
            const int d0 = 32 * j - 128 + 4 * hi - r32;
            ATT_LAS const float* tp = tmh + (d0 + 160);
            bf16x8 kf[4];
#pragma unroll
            for (int ks = 0; ks < 4; ++ks) kf[ks] = *(ATT_LAS const bf16x8*)(kb + ks * 32);
            float tb[16];
#pragma unroll
            for (int r = 0; r < 16; ++r) tb[r] = tp[crow(r, 0)];
            s16x4 va[8];
            { ATT_LAS const unsigned char* vb_ = lds + A_VB + brow * 128;
#pragma unroll
              for (int ks = 0; ks < 2; ++ks) { va[4 * ks] = vtr(vb_ + vrd0 + ks * 2048); va[4 * ks + 1] = vtr(vb_ + vrd0 + ks * 2048 + 1024); va[4 * ks + 2] = vtr(vb_ + vrd1 + ks * 2048); va[4 * ks + 3] = vtr(vb_ + vrd1 + ks * 2048 + 1024); } }
            f32x16 c = __builtin_amdgcn_mfma_f32_32x32x16_bf16(kf[0], qf[0], negm, 0, 0, 0);
#pragma unroll
            for (int ks = 1; ks < 4; ++ks) c = __builtin_amdgcn_mfma_f32_32x32x16_bf16(kf[ks], qf[ks], c, 0, 0, 0);
            if (blo < NMETA || blo + 31 >= LTOK) {
#pragma unroll
                for (int r = 0; r < 16; ++r) { const int pk = blo + 4 * hi + crow(r, 0); c[r] = (pk >= NMETA && pk < LTOK) ? c[r] + tb[r] : -INFINITY; }
            } else {
#pragma unroll
                for (int r = 0; r < 16; ++r) c[r] += tb[r];
            }
            A_SOFTPV_PRE(c, va);
        }
#undef A_SOFTPV_PRE
#undef A_SOFTPV
        asm volatile("s_waitcnt vmcnt(0)" : "+v"(gp[0]), "+v"(gp[1]), "+v"(gp[2]), "+v"(gp[3]), "+v"(qn[0]), "+v"(qn[1]), "+v"(qn[2]), "+v"(qn[3]), "+v"(nxt) :: "memory");
        if (ABL == 10) { if (o0[0] + o1[3] + lacc[2] == 12345.f) wsf[lane] = o0[1]; } else {
            const float inv = __builtin_amdgcn_rcpf(lacc[0]); float ss = 0.f;
            ATT_LAS unsigned char* stg = (ATT_LAS unsigned char*)wsf;
            const int sw = (r32 >> 2) & 3;
            bf16_t* Yb = (ABL ? (bf16_t*)(B.ws + WS_END) : B.Y()) + h * 64 + (lane & 3) * 8;
#pragma unroll
            for (int db = 0; db < 2; ++db) {
#pragma unroll
                for (int k = 0; k < 4; ++k) {
                    const float v0 = (db == 0 ? o0[4 * k] : o1[4 * k]) * inv, v1 = (db == 0 ? o0[4 * k + 1] : o1[4 * k + 1]) * inv, v2 = (db == 0 ? o0[4 * k + 2] : o1[4 * k + 2]) * inv, v3 = (db == 0 ? o0[4 * k + 3] : o1[4 * k + 3]) * inv;
                    ss += v0 * v0 + v1 * v1 + v2 * v2 + v3 * v3;
                    *(ATT_LAS u32x2*)(stg + r32 * 64 + ((k ^ sw) << 4) + 8 * hi) = (u32x2){cvtpk(v0, v1), cvtpk(v2, v3)};
                }
#pragma unroll
                for (int j = 0; j < 2; ++j) {
                    const int row = j * 16 + (lane >> 2), Pr = Pw + row;
                    const u32x4 ov = *(ATT_LAS const u32x4*)(stg + row * 64 + (((lane & 3) ^ ((row >> 2) & 3)) << 4));
                    const u32x4 gv = gp[db * 2 + j];
                    const unsigned ou[4] = {ov.x, ov.y, ov.z, ov.w}, gu[4] = {gv.x, gv.y, gv.z, gv.w}; unsigned yw[4];
#pragma unroll
                    for (int e = 0; e < 4; ++e) yw[e] = cvtpk(__uint_as_float(ou[e] << 16) * __uint_as_float(gu[e] << 16), __uint_as_float(ou[e] & 0xffff0000u) * __uint_as_float(gu[e] & 0xffff0000u));
                    if (Pr < LTOK) gstore16_wt(Yb + (rb + Pr) * 1024 + db * 32, (u32x4){yw[0], yw[1], yw[2], yw[3]});
                }
            }
            ss = xor32_sum(ss);
            if (ok && hi == 0) { float* sq = ABL ? (float*)(B.ws + WS_END + (size_t)MPAD * 2048) : B.ssqy(); sq[(size_t)h * MROWS + grow] = ss; }
        }
#pragma unroll
        for (int ks = 0; ks < 4; ++ks) qf_[ks] = qn[ks];
    }
    if (tid == 0) *uw = nxt;
    __syncthreads();
}

template <int ABL = 0>
__device__ __forceinline__ void attn_phase(const Params& p, const Bufs& B, int layer, ATT_LAS unsigned char* lds, int cidx = 0, int only = -1) {
    unsigned* ctr = (unsigned*)(p.ws + OFF_CTL) + 64 * (layer + 2 * cidx);
    volatile ATT_LAS unsigned* uw = (volatile ATT_LAS unsigned*)(lds + UWORD);
    const bool stat = (gridDim.x == 256);
    const bool dead_meta = (layer == 1);
    const int nst = stat ? 4 : 0, ubase = stat ? (dead_meta ? 1152 : 1024) : 0;
    const int cx = blockIdx.x & 7, cj = blockIdx.x >> 3;
    if (!stat) { if (threadIdx.x == 0) *uw = atomicAdd(ctr, 1u); __syncthreads(); }
    for (int it = 0;; ++it) {
        unsigned u; bool pf;
        if (it < nst) { u = (unsigned)(((it * 32 + cx * 4 + (cj >> 3)) << 3) + (cj & 7)); pf = (it == nst - 1); }
        else { u = ubase + *uw; pf = true; if (u >= (unsigned)NUNITS) break; }
        const bool skip = ((u < 1152) ? (only == 0) : (only == 1)) || (dead_meta && u >= 1024 && u < 1152);
        if (skip) { __syncthreads(); if (pf && threadIdx.x == 0) *uw = atomicAdd(ctr, 1u); __syncthreads(); continue; }
        if (u < 1152) { const int bh = u < 1024 ? (int)(u >> 3) : (int)u - 1024, qt = u < 1024 ? (int)(u & 7) : 8;
            const bool st_ = (it < nst) && only < 0;
            if (st_ && it + 1 < nst) attn_unit_b<ABL, true>(B, bh >> 3, bh & 7, qt, lds, ctr, uw, pf, it > 0);
            else attn_unit_b<ABL, false>(B, bh >> 3, bh & 7, qt, lds, ctr, uw, pf, st_ && it > 0); }
        else { const int i = u - 1152; int bg, qb; if (i < 512) { bg = i >> 4; qb = i & 15; } else { bg = i - 512; qb = 16; }
            attn_unit_a2<ABL>(p, B, layer, bg >> 1, bg & 1, qb, lds, ctr, uw); }
    }
}
}

__device__ __forceinline__ void phase_final(const Params& p, const Bufs& B) {
    const int lane = threadIdx.x & 63, gw = blockIdx.x * 8 + (threadIdx.x >> 6), NGW = gridDim.x * 8;
    for (int i0 = gw * 8; i0 < NBATCH * SEQ; i0 += NGW * 8) {
        uint2 hv[8][4]; float rs[8];
#pragma unroll
        for (int q = 0; q < 8; ++q) {
            const int i = i0 + q, b = i / SEQ, sq = i % SEQ, r = b * LTOK + NMETA + sq;
#pragma unroll
            for (int j = 0; j < 4; ++j) hv[q][j] = *(const uint2*)(B.H() + (size_t)r * DM + j * 256 + lane * 4);
            rs[q] = row_rs16(B.ssqh(), r, 1.0f / 1024.0f);
        }
#pragma unroll
        for (int j = 0; j < 4; ++j) {
            const int c = j * 256 + lane * 4; const float4 g = *(const float4*)(p.norm_f + c);
#pragma unroll
            for (int q = 0; q < 8; ++q) {
                float4 o; o.x = __uint_as_float(hv[q][j].x << 16) * rs[q] * g.x; o.y = __uint_as_float(hv[q][j].x & 0xffff0000u) * rs[q] * g.y;
                o.z = __uint_as_float(hv[q][j].y << 16) * rs[q] * g.z; o.w = __uint_as_float(hv[q][j].y & 0xffff0000u) * rs[q] * g.w;
                __builtin_nontemporal_store((nt_f4){o.x, o.y, o.z, o.w}, (nt_f4*)(p.out + (size_t)(i0 + q) * DM + c));
            }
        }
    }
}

constexpr int LDS_BYTES = 147456;

#define XB_TMO      128
#define XB_XCNT(j)  (256  + 64 * (j))
#define XB_XSUB(j)  (1280 + 64 * (j))
#define XB_XGEN(j)  (2304 + 64 * (j))
#define XB_TOP      3328
#define XB_TOPGEN   3392
#define XCD_BAR_WORDS 3456
#define XB_SPIN_CAP (1u << 18)
#define XB_LAS __attribute__((address_space(3)))
constexpr int BAR_WORD0 = 2048;
constexpr int LDS_BAR_OFF = 147456 - 64;
__device__ __forceinline__ unsigned xb_ld(unsigned* p)              { return __hip_atomic_load(p, __ATOMIC_RELAXED, __HIP_MEMORY_SCOPE_AGENT); }
__device__ __forceinline__ unsigned xb_add(unsigned* p, unsigned v) { return __hip_atomic_fetch_add(p, v, __ATOMIC_RELAXED, __HIP_MEMORY_SCOPE_AGENT); }
__device__ __forceinline__ unsigned xb_xcc_id() { return (unsigned)__builtin_amdgcn_s_getreg((3 << 11) | 20) & 0xFu; }
#define XB_SPIN(cond, bar) do { unsigned _sp = 0; while (cond) { __builtin_amdgcn_s_sleep(1); \
    if ((++_sp & 255u) == 0u) { if (xb_ld(&(bar)[XB_TMO])) break; if (_sp > XB_SPIN_CAP) { atomicAdd(&(bar)[XB_TMO], 1u); break; } } } } while (0)
__device__ __forceinline__ void xcd_barrier_post(unsigned* bar) { if (threadIdx.x == 0) (void)xb_add(&bar[XB_XCNT(xb_xcc_id())], 1u); }
__device__ __forceinline__ void xcd_barrier_complete(unsigned* bar, unsigned x, unsigned& nloc, unsigned& nx) {
    const unsigned G = gridDim.x * gridDim.y * gridDim.z;
    unsigned sum, cnt, mine, sp = 0u;
    for (;;) {
        sum = 0u; cnt = 0u; mine = 0u;
#pragma unroll
        for (unsigned j = 0; j < 16; ++j) { const unsigned c = xb_ld(&bar[XB_XCNT(j)]); sum += c; cnt += (c > 0u) ? 1u : 0u; mine = (j == x) ? c : mine; }
        if (sum == G) break;
        __builtin_amdgcn_s_sleep(1);
        if ((++sp & 255u) == 0u) { if (xb_ld(&bar[XB_TMO])) break; if (sp > XB_SPIN_CAP) { atomicAdd(&bar[XB_TMO], 1u); break; } }
    }
    nloc = mine > 0u ? mine : 1u; nx = cnt > 0u ? cnt : 1u;
}
__device__ __forceinline__ void xcd_barrier(unsigned* bar, volatile XB_LAS unsigned* st) {
    asm volatile("s_waitcnt vmcnt(0)" ::: "memory");
    __syncthreads();
    if (threadIdx.x == 0) {
        const unsigned x = xb_xcc_id();
        __builtin_amdgcn_s_waitcnt(0);
        unsigned nloc = st[0], nx = st[1];
        if (nloc == 0u) { xcd_barrier_complete(bar, x, nloc, nx); st[0] = nloc; st[1] = nx; }
        const unsigned old = xb_add(&bar[XB_XSUB(x)], 1u);
        const unsigned gen = old / nloc;
        if (old + 1u == (gen + 1u) * nloc) {
            __builtin_amdgcn_fence(__ATOMIC_RELEASE, "agent");
            asm volatile("s_waitcnt vmcnt(0)" ::: "memory");
            const unsigned og = xb_add(&bar[XB_TOP], 1u);
            const unsigned tg = og / nx;
            if (og + 1u == (tg + 1u) * nx) xb_add(&bar[XB_TOPGEN], 1u);
            else XB_SPIN(xb_ld(&bar[XB_TOPGEN]) == tg, bar);
            __builtin_amdgcn_fence(__ATOMIC_ACQUIRE, "agent");
            xb_add(&bar[XB_XGEN(x)], 1u);
            asm volatile("s_waitcnt vmcnt(0)" ::: "memory");
        } else {
            XB_SPIN(xb_ld(&bar[XB_XGEN(x)]) == gen, bar);
            __builtin_amdgcn_fence(__ATOMIC_ACQUIRE, "agent");
            asm volatile("s_waitcnt vmcnt(0)" ::: "memory");
        }
    }
    __syncthreads();
}

typedef const __attribute__((address_space(4))) Params* kparams_t;
__device__ __forceinline__ Params load_params() {
    kparams_t q = (kparams_t)__builtin_amdgcn_kernarg_segment_ptr(); asm volatile("" : "+s"(q));
    Params r;
    r.x = q->x; r.meta = q->meta; r.relb = q->relb; r.norm_in = q->norm_in; r.w_in = q->w_in; r.sink = q->sink; r.norm_q = q->norm_q; r.w_uq = q->w_uq;
    r.norm_kv = q->norm_kv; r.w_ukv = q->w_ukv; r.norm_oa = q->norm_oa; r.norm_ob = q->norm_ob; r.w_out = q->w_out; r.norm_f = q->norm_f; r.out = q->out; r.ws = q->ws;
    return r;
}
#if USE_CG_SYNC
#define GRID_SYNC() cg::this_grid().sync()
#else
#define GRID_SYNC() do { const Params pb_ = load_params(); xcd_barrier((unsigned*)(pb_.ws + OFF_CTL) + BAR_WORD0, (volatile XB_LAS unsigned*)((XB_LAS unsigned char*)lds_raw + LDS_BAR_OFF)); } while (0)
#endif
template <int l>
__device__ __forceinline__ void run_layer(unsigned char* lds_raw) {
    float* ldsf = (float*)lds_raw; PG8_LAS unsigned char* ldsl = (PG8_LAS unsigned char*)lds_raw;
    { const Params p = load_params(); const Bufs B = make_bufs(p.ws); phase_inproj(ldsl, p, B, l); }
    GRID_SYNC();
#if PROBE_REP == 1
    { const Params p = load_params(); const Bufs B = make_bufs(p.ws); phase_inproj(ldsl, p, B, l); }
    GRID_SYNC();
#endif
    { const Params p = load_params(); const Bufs B = make_bufs(p.ws); phase_upproj(ldsl, B, l); }
    GRID_SYNC();
#if PROBE_REP == 2
    { const Params p = load_params(); const Bufs B = make_bufs(p.ws); phase_upproj(ldsl, B, l); }
    GRID_SYNC();
#endif
    { const Params p = load_params(); const Bufs B = make_bufs(p.ws); att::attn_phase(p, B, l, ldsl); }
    GRID_SYNC();
#if PROBE_REP == 3
    { const Params p = load_params(); const Bufs B = make_bufs(p.ws); att::attn_phase(p, B, l, ldsl, 1); }
    GRID_SYNC();
#endif
#if PROBE_REP == 5 || PROBE_REP == 6
    { const Params p = load_params(); const Bufs B = make_bufs(p.ws); att::attn_phase<PROBE_ABL>(p, B, l, ldsl, 1, PROBE_REP == 5 ? 1 : 0); }
    GRID_SYNC();
#endif
#if PROBE_REP == 4
    GRID_SYNC(); GRID_SYNC(); GRID_SYNC(); GRID_SYNC(); GRID_SYNC();
#endif
    { const Params p = load_params(); const Bufs B = make_bufs(p.ws); phase_outproj(ldsl, B, l); }
    GRID_SYNC();
}
__global__ void __launch_bounds__(NTHREADS) fwd_kernel(Params p_unused) {
    extern __shared__ __attribute__((aligned(16))) unsigned char lds_raw[];
#if !USE_CG_SYNC
    if (threadIdx.x == 0) { volatile XB_LAS unsigned* st = (volatile XB_LAS unsigned*)((XB_LAS unsigned char*)lds_raw + LDS_BAR_OFF); st[0] = 0u; st[1] = 0u; }
    __syncthreads();
    { const Params p = load_params(); xcd_barrier_post((unsigned*)(p.ws + OFF_CTL) + BAR_WORD0); }
#endif
    { const Params p = load_params(); const Bufs B = make_bufs(p.ws); phase_prologue(p, B, (float*)lds_raw); }
    GRID_SYNC();
#if PROBE_REP == 7
    { const Params p = load_params(); const Bufs B = make_bufs(p.ws); phase_prologue(p, B, (float*)lds_raw); }
    GRID_SYNC();
#endif
    run_layer<0>(lds_raw);
    run_layer<1>(lds_raw);
    { const Params p = load_params(); const Bufs B = make_bufs(p.ws); phase_final(p, B); }
#if PROBE_REP == 8
    GRID_SYNC();
    { const Params p = load_params(); const Bufs B = make_bufs(p.ws); phase_final(p, B); }
#endif
}

extern "C" void kernel_launch(void* const* d_in, const int* in_sizes, int n_in, void* d_out, int out_size, void* d_ws, size_t ws_size, hipStream_t stream) {
    static int grid_blocks = 0;
    if (grid_blocks == 0) {
        if (n_in != 14 || ws_size < WS_END + (PROBE_ABL ? (size_t)MPAD * 2048 + (size_t)32 * MROWS * 4 : 0)) { fprintf(stderr, "kernel_launch: unexpected n_in %d or ws_size %zu (need %zu)\n", n_in, ws_size, (size_t)WS_END); grid_blocks = -1; return; }
        int dev = 0, cus = 0, per_cu = 0;
        hipGetDevice(&dev);
        hipDeviceGetAttribute(&cus, hipDeviceAttributeMultiprocessorCount, dev);
        hipFuncSetAttribute((const void*)fwd_kernel, hipFuncAttributeMaxDynamicSharedMemorySize, LDS_BYTES);
        hipOccupancyMaxActiveBlocksPerMultiprocessor(&per_cu, (const void*)fwd_kernel, NTHREADS, LDS_BYTES);
        if (per_cu < 1) { fprintf(stderr, "kernel_launch: occupancy query says %d blocks per CU\n", per_cu); per_cu = 1; }
        if (per_cu > 1) per_cu = 1;
        grid_blocks = cus * per_cu;
        (void)hipGetLastError();
    }
    if (grid_blocks < 0) return;
    Params p{};
    p.x = (const float*)d_in[0]; p.meta = (const float*)d_in[1]; p.relb = (const float*)d_in[2]; p.norm_in = (const float*)d_in[3]; p.w_in = (const float*)d_in[4];
    p.sink = (const float*)d_in[5]; p.norm_q = (const float*)d_in[6]; p.w_uq = (const float*)d_in[7]; p.norm_kv = (const float*)d_in[8]; p.w_ukv = (const float*)d_in[9];
    p.norm_oa = (const float*)d_in[10]; p.norm_ob = (const float*)d_in[11]; p.w_out = (const float*)d_in[12]; p.norm_f = (const float*)d_in[13];
    p.out = (float*)d_out; p.ws = (unsigned char*)d_ws;
    if (hipMemsetAsync((char*)d_ws + OFF_CTL, 0, CTL_BYTES, stream) != hipSuccess) { fprintf(stderr, "kernel_launch: memset of control words failed\n"); return; }
    void* args[] = {&p};
    hipError_t e = hipLaunchCooperativeKernel((const void*)fwd_kernel, dim3(grid_blocks), dim3(NTHREADS), args, LDS_BYTES, stream);
    if (e != hipSuccess) fprintf(stderr, "cooperative launch failed: %s (grid %d)\n", hipGetErrorString(e), grid_blocks);
}
```
